# Optimizing an MI355X kernel written in HIP

```python
import jax, jax.numpy as jnp
from jax import lax
import numpy as np

D_MODEL = 1024
BATCH = 16
SEQ = 4096
DEPTH = 1

HEAD_DIM = 64
N_HEADS_NSA = 8
N_KV_NSA = 2
GROUP = N_HEADS_NSA // N_KV_NSA
N_HEADS_FOX = 8
D_NSA = N_HEADS_NSA * HEAD_DIM
D_KV_NSA = N_KV_NSA * HEAD_DIM
D_FOX = N_HEADS_FOX * HEAD_DIM
CMP_BLOCK = 32
CMP_STRIDE = 16
CMP_RATIO = CMP_BLOCK // CMP_STRIDE
CMP_HIDDEN = 128
SLC_BLOCK = 64
TOP_N = 16
WINDOW = 512
NSA_Q_BLOCK = 64
Q_BLOCK = 128
ROPE_THETA = 500000.0
ROPE_DIM = HEAD_DIM // 4
D_FF = 2816
N_MOD = 9
RMS_EPS = 1e-6
NEG_INF = -1e30
FORCE_SCORE = 1e4
IN_SIZES = (D_NSA, D_KV_NSA, D_KV_NSA, D_KV_NSA, D_KV_NSA, D_KV_NSA, D_KV_NSA,
            3 * N_HEADS_NSA, D_FOX, D_FOX, D_FOX, N_HEADS_FOX, D_MODEL, D_MODEL)
D_IN = sum(IN_SIZES)

kernel_name = "macaron_nsa_fox_hybrid_adaln"


def rms_norm(x, g):
    xf = x.astype(jnp.float32)
    y = xf * lax.rsqrt(jnp.mean(xf * xf, axis=-1, keepdims=True) + RMS_EPS)
    return (y * g.astype(jnp.float32)).astype(x.dtype)


def modulate(h, shift, scale):
    return h * (1 + scale[:, None, :]) + shift[:, None, :]


def swiglu(h, w_gate, w_up, w_down):
    return (jax.nn.silu(h @ w_gate) * (h @ w_up)) @ w_down


def partial_rope(x, positions):
    half = ROPE_DIM // 2
    inv_freq = ROPE_THETA ** (-jnp.arange(half, dtype=jnp.float32) / half)
    ang = positions.astype(jnp.float32)[..., None] * inv_freq
    cos = jnp.cos(ang)[:, :, None, :]
    sin = jnp.sin(ang)[:, :, None, :]
    xr = x[..., :ROPE_DIM].astype(jnp.float32)
    x1, x2 = xr[..., :half], xr[..., half:]
    rot = jnp.concatenate([x1 * cos - x2 * sin, x2 * cos + x1 * sin], axis=-1).astype(x.dtype)
    return jnp.concatenate([rot, x[..., ROPE_DIM:]], axis=-1)


def masked_softmax(s, mask):
    p = jax.nn.softmax(jnp.where(mask, s, NEG_INF), axis=-1)
    return jnp.where(mask, p, 0.0)


def compress_blocks(kv, pe, w1, w2):
    B, T, G, dh = kv.shape
    n_sub = T // CMP_STRIDE
    n_cmp = n_sub - CMP_RATIO + 1
    sub = kv.reshape(B, n_sub, CMP_STRIDE, G, dh)
    blocks = jnp.concatenate([sub[:, i:i + n_cmp] for i in range(CMP_RATIO)], axis=2)
    blocks = blocks + pe[None, None, :, None, :]
    flat = blocks.transpose(0, 1, 3, 2, 4).reshape(B, n_cmp, G, CMP_BLOCK * dh)
    return jax.nn.gelu(flat @ w1) @ w2


def nsa_attention(q, k_cmp, v_cmp, k_slc, v_slc, k_win, v_win, gates,
                  pe_ck, w1_ck, w2_ck, pe_cv, w1_cv, w2_cv):
    B, T, H, dh = q.shape
    G = k_cmp.shape[2]
    scale = dh ** -0.5
    kc = compress_blocks(k_cmp, pe_ck, w1_ck, w2_ck)
    vc = compress_blocks(v_cmp, pe_cv, w1_cv, w2_cv)
    n_cmp = kc.shape[1]
    n_slc = T // SLC_BLOCK
    n_sel = min(TOP_N, n_slc)
    cmp_start = jnp.arange(n_cmp) * CMP_STRIDE
    cmp_end = cmp_start + CMP_BLOCK - 1
    slc_start = jnp.arange(n_slc) * SLC_BLOCK
    overlap = ((cmp_start[:, None] < slc_start[None, :] + SLC_BLOCK)
               & (slc_start[None, :] < cmp_start[:, None] + CMP_BLOCK)).astype(jnp.float32)
    ks_blocks = k_slc.reshape(B, n_slc, SLC_BLOCK, G, dh).transpose(0, 3, 1, 2, 4)
    vs_blocks = v_slc.reshape(B, n_slc, SLC_BLOCK, G, dh).transpose(0, 3, 1, 2, 4)
    kw_pad = jnp.pad(k_win, ((0, 0), (WINDOW, 0), (0, 0), (0, 0)))
    vw_pad = jnp.pad(v_win, ((0, 0), (WINDOW, 0), (0, 0), (0, 0)))
    qg = q.reshape(B, T, G, GROUP, dh)
    b_idx = jnp.arange(B)[:, None, None, None]
    g_idx = jnp.arange(G)[None, :, None, None]
    blk = jnp.arange(n_slc)
    span = NSA_Q_BLOCK + WINDOW
    Q = NSA_Q_BLOCK

    def block(i):
        q0 = i * Q
        qb = lax.dynamic_slice_in_dim(qg, q0, Q, axis=1)
        gb = lax.dynamic_slice_in_dim(gates, q0, Q, axis=1).reshape(B, Q, G, GROUP, 3)
        t = q0 + jnp.arange(Q)
        s = jnp.einsum('bqgrd,bcgd->bgrqc', qb, kc, preferred_element_type=jnp.float32) * scale
        p_cmp = masked_softmax(s, cmp_end[None, :] <= t[:, None])
        o_cmp = jnp.einsum('bgrqc,bcgd->bqgrd', p_cmp, vc)
        imp = jnp.einsum('bgrqc,cn->bgqn', p_cmp, overlap)
        cur = t // SLC_BLOCK
        visible = blk[None, :] <= cur[:, None]
        forced = (blk[None, :] == 0) | (blk[None, :] == cur[:, None]) | (blk[None, :] == cur[:, None] - 1)
        imp = jnp.where(forced, FORCE_SCORE, jnp.where(visible, imp, -1.0))
        _, idx = lax.top_k(imp, n_sel)
        ks = ks_blocks[b_idx, g_idx, idx]
        vs = vs_blocks[b_idx, g_idx, idx].reshape(B, G, Q, n_sel * SLC_BLOCK, dh)
        s = jnp.einsum('bqgrd,bgqnld->bgrqnl', qb, ks, preferred_element_type=jnp.float32) * scale
        s = s.reshape(B, G, GROUP, Q, n_sel * SLC_BLOCK)
        key_pos = idx[..., None] * SLC_BLOCK + jnp.arange(SLC_BLOCK)
        mask_s = (key_pos <= t[None, None, :, None, None]).reshape(B, G, 1, Q, n_sel * SLC_BLOCK)
        p = masked_softmax(s, mask_s)
        o_slc = jnp.einsum('bgrqm,bgqmd->bqgrd', p, vs)
        kw = lax.dynamic_slice_in_dim(kw_pad, q0, span, axis=1)
        vw = lax.dynamic_slice_in_dim(vw_pad, q0, span, axis=1)
        s = jnp.einsum('bqgrd,bkgd->bgrqk', qb, kw, preferred_element_type=jnp.float32) * scale
        kpos = q0 - WINDOW + jnp.arange(span)
        mask_w = (kpos[None, :] >= 0) & (kpos[None, :] <= t[:, None]) & (t[:, None] - kpos[None, :] < WINDOW)
        p = masked_softmax(s, mask_w)
        o_win = jnp.einsum('bgrqk,bkgd->bqgrd', p, vw)
        o = gb[..., 0:1] * o_cmp + gb[..., 1:2] * o_slc + gb[..., 2:3] * o_win
        return o.reshape(B, Q, H * dh).astype(q.dtype)

    out = lax.map(block, jnp.arange(T // Q))
    return out.transpose(1, 0, 2, 3).reshape(B, T, H * dh)


def forgetting_attention(q, k, v, log_f):
    B, T, H, dh = q.shape
    scale = dh ** -0.5
    cf = lax.cumsum(log_f, axis=1).transpose(0, 2, 1)
    kpos = jnp.arange(T)

    def block(i):
        q0 = i * Q_BLOCK
        qb = lax.dynamic_slice_in_dim(q, q0, Q_BLOCK, axis=1)
        cq = lax.dynamic_slice_in_dim(cf, q0, Q_BLOCK, axis=2)
        t = q0 + jnp.arange(Q_BLOCK)
        s = jnp.einsum('bqhd,bkhd->bhqk', qb, k, preferred_element_type=jnp.float32) * scale
        s = s + (cq[..., :, None] - cf[..., None, :])
        p = masked_softmax(s, kpos[None, :] <= t[:, None])
        o = jnp.einsum('bhqk,bkhd->bqhd', p, v)
        return o.reshape(B, Q_BLOCK, H * dh).astype(q.dtype)

    out = lax.map(block, jnp.arange(T // Q_BLOCK))
    return out.transpose(1, 0, 2, 3).reshape(B, T, H * dh)


def hybrid_mixer(h, positions, w_in, b_forget, pe_ck, w1_ck, w2_ck, pe_cv, w1_cv, w2_cv,
                 w_up_nsa, w_up_fox, w_o):
    B, T, _ = h.shape
    split_points = [int(s) for s in np.cumsum(IN_SIZES)[:-1]]
    (q_n, k_c, v_c, k_s, v_s, k_w, v_w, gate_n, q_f, k_f, v_f, f_logit,
     gm_nsa, gm_fox) = jnp.split(h @ w_in, split_points, axis=-1)

    def heads(a, n):
        return a.reshape(B, T, n, HEAD_DIM)

    o_nsa = nsa_attention(
        partial_rope(heads(q_n, N_HEADS_NSA), positions),
        partial_rope(heads(k_c, N_KV_NSA), positions), heads(v_c, N_KV_NSA),
        partial_rope(heads(k_s, N_KV_NSA), positions), heads(v_s, N_KV_NSA),
        partial_rope(heads(k_w, N_KV_NSA), positions), heads(v_w, N_KV_NSA),
        jax.nn.sigmoid(gate_n.reshape(B, T, N_HEADS_NSA, 3)),
        pe_ck, w1_ck, w2_ck, pe_cv, w1_cv, w2_cv)
    log_f = jax.nn.log_sigmoid((f_logit + b_forget).astype(jnp.float32))
    o_fox = forgetting_attention(heads(q_f, N_HEADS_FOX), heads(k_f, N_HEADS_FOX),
                                 heads(v_f, N_HEADS_FOX), log_f)
    merged = jax.nn.sigmoid(gm_nsa) * (o_nsa @ w_up_nsa) + jax.nn.sigmoid(gm_fox) * (o_fox @ w_up_fox)
    return merged @ w_o


def setup_inputs(seed: int = 0) -> dict:
    key = jax.random.key(seed)
    ks = jax.random.split(key, 32)
    L, D = DEPTH, D_MODEL

    def w(k, shape, fan_in, mult=1.0):
        return jax.random.normal(k, shape, jnp.float32) * (mult * fan_in ** -0.5)

    def gain(k, shape):
        return 1.0 + 0.05 * jax.random.normal(k, shape, jnp.float32)

    return {
        'x': jax.random.normal(ks[0], (BATCH, SEQ, D), jnp.float32),
        'c': jax.random.normal(ks[1], (BATCH, D), jnp.float32),
        'positions': (jnp.arange(SEQ, dtype=jnp.int32)[None, :]
                      + jax.random.randint(ks[2], (BATCH, 1), 0, 1024, dtype=jnp.int32)),
        'w_ada': w(ks[3], (L, D, N_MOD * D), D, 0.5),
        'b_ada': 0.02 * jax.random.normal(ks[4], (L, N_MOD * D), jnp.float32),
        'g_ffn1': gain(ks[5], (L, D)),
        'w_gate1': w(ks[6], (L, D, D_FF), D),
        'w_up1': w(ks[7], (L, D, D_FF), D),
        'w_down1': w(ks[8], (L, D_FF, D), D_FF),
        'g_mix': gain(ks[9], (L, D)),
        'w_in': w(ks[10], (L, D, D_IN), D),
        'b_forget': 3.0 + 0.5 * jax.random.normal(ks[11], (L, N_HEADS_FOX), jnp.float32),
        'pe_ck': 0.5 * jax.random.normal(ks[12], (L, CMP_BLOCK, HEAD_DIM), jnp.float32),
        'w1_ck': w(ks[13], (L, CMP_BLOCK * HEAD_DIM, CMP_HIDDEN), CMP_BLOCK * HEAD_DIM),
        'w2_ck': w(ks[14], (L, CMP_HIDDEN, HEAD_DIM), CMP_HIDDEN),
        'pe_cv': 0.5 * jax.random.normal(ks[15], (L, CMP_BLOCK, HEAD_DIM), jnp.float32),
        'w1_cv': w(ks[16], (L, CMP_BLOCK * HEAD_DIM, CMP_HIDDEN), CMP_BLOCK * HEAD_DIM),
        'w2_cv': w(ks[17], (L, CMP_HIDDEN, HEAD_DIM), CMP_HIDDEN),
        'w_up_nsa': w(ks[18], (L, D_NSA, D), D_NSA),
        'w_up_fox': w(ks[19], (L, D_FOX, D), D_FOX),
        'w_o': w(ks[20], (L, D, D), D),
        'g_ffn2': gain(ks[21], (L, D)),
        'w_gate2': w(ks[22], (L, D, D_FF), D),
        'w_up2': w(ks[23], (L, D, D_FF), D),
        'w_down2': w(ks[24], (L, D_FF, D), D_FF),
        'g_final': gain(ks[25], (D,)),
    }


def reference(x, c, positions, w_ada, b_ada, g_ffn1, w_gate1, w_up1, w_down1, g_mix, w_in,
              b_forget, pe_ck, w1_ck, w2_ck, pe_cv, w1_cv, w2_cv, w_up_nsa, w_up_fox, w_o,
              g_ffn2, w_gate2, w_up2, w_down2, g_final):
    c_act = jax.nn.silu(c)
    for l in range(DEPTH):
        mod = c_act @ w_ada[l] + b_ada[l]
        sh1, sc1, ga1, sh2, sc2, ga2, sh3, sc3, ga3 = jnp.split(mod, N_MOD, axis=-1)
        h = modulate(rms_norm(x, g_ffn1[l]), sh1, sc1)
        x = x + 0.5 * ga1[:, None, :] * swiglu(h, w_gate1[l], w_up1[l], w_down1[l])
        h = modulate(rms_norm(x, g_mix[l]), sh2, sc2)
        y = hybrid_mixer(h, positions, w_in[l], b_forget[l], pe_ck[l], w1_ck[l], w2_ck[l],
                         pe_cv[l], w1_cv[l], w2_cv[l], w_up_nsa[l], w_up_fox[l], w_o[l])
        x = x + ga2[:, None, :] * y
        h = modulate(rms_norm(x, g_ffn2[l]), sh3, sc3)
        x = x + 0.5 * ga3[:, None, :] * swiglu(h, w_gate2[l], w_up2[l], w_down2[l])
    return rms_norm(x, g_final)
```

```cpp
#include <hip/hip_runtime.h>
#include <hip/hip_cooperative_groups.h>
#include <cstdio>
#include <cstdint>
#include <cmath>
namespace cg = cooperative_groups;
namespace pg8 {
#define PG8_LAS __attribute__((address_space(3)))
typedef unsigned short bf16_t;
typedef short bf16x8 __attribute__((ext_vector_type(8)));
typedef float f32x4 __attribute__((ext_vector_type(4)));
typedef unsigned u32x4 __attribute__((ext_vector_type(4)));
constexpr int BM = 256, BK = 64, HALF = 128, HTB = HALF * BK * 2  , STAGE_BYTES = 8 * HTB, NXCD = 8, WGM = 8;

__host__ __device__ __forceinline__ int lds_byte(int r, int c) { const int st = (r >> 4) * 2 + (c >> 5), rr = r & 15, cc = c & 31, ob = rr * 64 + cc * 2; return st * 1024 + (ob ^ (((ob >> 9) & 1) << 5)); }
__host__ __device__ __forceinline__ void stage_rc(int b, int& R, int& C) { const int st = b / 1024, sb = b % 1024, swz = sb ^ (((sb >> 9) & 1) << 5); R = (st >> 1) * 16 + swz / 64; C = (st & 1) * 32 + (swz % 64) / 2; }
__host__ __device__ __forceinline__ int perm32(int rho) { const int n = rho >> 4, i = rho & 15; return 8 * (i >> 2) + 4 * n + (i & 3); }

struct Unit { int pm, pn; };
struct Gemm { const bf16_t* A; const bf16_t* Bt; int M, N, K; };

struct StaticOrder {
    int nM, nN, nwg, G, c;
    __host__ __device__ void init(int M, int N, int G_, int c_) { nM = M / BM; nN = N / BM; nwg = nM * nN; G = G_; c = c_; }
    __host__ __device__ bool next(int i, Unit& u) const {
        const long L = (long)i * G + c; if (L >= nwg) return false;
        int wgid = (int)L; { const int q = nwg / NXCD, r = nwg % NXCD, xcd = wgid % NXCD, off = wgid / NXCD; wgid = (xcd < r ? xcd * (q + 1) : r * (q + 1) + (xcd - r) * q) + off; }
        const int nig = WGM * nN, gid = wgid / nig, fm = gid * WGM, gsz = (nM - fm) < WGM ? (nM - fm) : WGM;
        u.pm = fm + ((wgid % nig) % gsz); u.pn = (wgid % nig) / gsz; return true;
    }
    __device__ __forceinline__ void a_ready(const Unit&) const {}
    __device__ __forceinline__ void done(const Unit&) const {}
};

__device__ __forceinline__ unsigned cvt_pk_bf16(float lo, float hi) { unsigned r; asm volatile("v_cvt_pk_bf16_f32 %0, %1, %2" : "=v"(r) : "v"(lo), "v"(hi)); return r; }
typedef float f32x2 __attribute__((ext_vector_type(2)));
__device__ __forceinline__ f32x2 gelu_pk(f32x2 v) {
    const f32x2 av = __builtin_elementwise_abs(v), d = av * 0.2316418882f + 1.0f;
    f32x2 t; t.x = __builtin_amdgcn_rcpf(d.x); t.y = __builtin_amdgcn_rcpf(d.y);
    f32x2 q = t * 0.5307027145f + (-0.7265760135f); q = q * t + 0.7107068705f; q = q * t + (-0.142248368f); q = q * t + 0.127414796f; q = q * t;
    const f32x2 s = (v * v) * (-0.72134752044f);
    f32x2 e; e.x = __builtin_amdgcn_exp2f(s.x); e.y = __builtin_amdgcn_exp2f(s.y);
    const f32x2 m = v * (q * e), r = v - m;
    f32x2 o; o.x = v.x < 0.f ? m.x : r.x; o.y = v.y < 0.f ? m.y : r.y; return o;
}

template <int ACT  > struct EpiBf16 {
    static constexpr bool PERM = true, AFTER_DRAIN = false; static_assert(ACT == 0 || ACT == 1, "EpiBf16: ACT is 0 (none) or 1 (gelu_pk)");
    bf16_t* O; int ldc; const float* bias; int split_cols; size_t split_stride; float scale0;
    __device__ __forceinline__ void operator()(const f32x4 (&acc)[2][2][4][2], const Unit& u, int wr, int wc, int fr, int fq) const {
        const int row0 = u.pm * BM + wr * 64 + fr; int colt = u.pn * BM; bf16_t* base = O;
        float sc = 1.f; if (split_cols) { const int t = colt / split_cols; base += (size_t)t * split_stride; colt -= t * split_cols; if (t == 0) sc = scale0; }
        const int col0 = colt + wc * 32 + 8 * fq, bcol0 = u.pn * BM + wc * 32 + 8 * fq;
        f32x4 bv[2][2];
#pragma unroll
        for (int bj = 0; bj < 2; ++bj)
#pragma unroll
            for (int n = 0; n < 2; ++n) bv[bj][n] = bias ? *(const f32x4*)(bias + bcol0 + bj * HALF + 4 * n) : (f32x4){0.f, 0.f, 0.f, 0.f};
#pragma unroll
        for (int ai = 0; ai < 2; ++ai)
#pragma unroll
            for (int m = 0; m < 4; ++m) { bf16_t* rowp = base + (size_t)(row0 + ai * HALF + m * 16) * ldc + col0;
#pragma unroll
                for (int bj = 0; bj < 2; ++bj) { f32x4 v0 = acc[ai][bj][m][0] + bv[bj][0], v1 = acc[ai][bj][m][1] + bv[bj][1];
                    if (ACT == 1) { f32x2 a = gelu_pk((f32x2){v0[0], v0[1]}), b = gelu_pk((f32x2){v0[2], v0[3]}), c = gelu_pk((f32x2){v1[0], v1[1]}), d = gelu_pk((f32x2){v1[2], v1[3]});
                        v0 = (f32x4){a.x, a.y, b.x, b.y}; v1 = (f32x4){c.x, c.y, d.x, d.y}; }
                    v0 = v0 * sc; v1 = v1 * sc; u32x4 w; w.x = cvt_pk_bf16(v0[0], v0[1]); w.y = cvt_pk_bf16(v0[2], v0[3]); w.z = cvt_pk_bf16(v1[0], v1[1]); w.w = cvt_pk_bf16(v1[2], v1[3]);
                    *(u32x4*)(rowp + bj * HALF) = w; } }
    }
};
template <class Epi, class Sched, bool ALIGN_EPI = false, bool SP2 = false>
__device__ __forceinline__ void gemm_phase(PG8_LAS unsigned char* lds, const Gemm g, const Sched& S, const Epi& E) {
    int tid_ = threadIdx.x; asm volatile("" : "+v"(tid_));
    const int tid = tid_, wid = __builtin_amdgcn_readfirstlane(tid >> 6), lane = tid & 63, wr = wid >> 2, wc = wid & 3, fr = lane & 15, fq = lane >> 4;
    const int K = g.K, nt = K / BK;
    unsigned voffA[2], voffB[2];
#pragma unroll
    for (int i = 0; i < 2; ++i) { int R, C; stage_rc(tid * 16 + i * 8192, R, C); const int Rb = Epi::PERM ? ((R & ~31) + perm32(R & 31)) : R;
        voffA[i] = (unsigned)(R * K + C) * 2u; voffB[i] = (unsigned)(Rb * K + C) * 2u; }
    const size_t kstep = (size_t)(BK * 2);
    const size_t hstep = (size_t)HALF * K * 2;
    const size_t tstep = 2 * hstep;
    const unsigned ldsw = (unsigned)wid * 1024u;
    const int aoff = lds_byte(wr * 64 + fr, fq * 8), boff = lds_byte(wc * 32 + fr, fq * 8);
#define PG8_SA(b, h) (((b) * 2 + (h)) * HTB)
#define PG8_SB(b, h) ((4 + (b) * 2 + (h)) * HTB)
#define PG8_STAGE(bufoff, gbase, voff) do { _Pragma("unroll") for (int _i = 0; _i < 2; ++_i) \
        __builtin_amdgcn_global_load_lds((const unsigned*)((const char*)(gbase) + (voff)[_i]), (PG8_LAS unsigned*)(lds + (bufoff) + ldsw + _i * 8192), 16, 0, 0); } while (0)
#define PG8_LDA(dst, b, h) do { _Pragma("unroll") for (int m = 0; m < 4; ++m) _Pragma("unroll") for (int k = 0; k < 2; ++k) dst[m][k] = *(const PG8_LAS bf16x8*)(lds + PG8_SA(b, h) + aoff + m * 2048 + k * 1024); } while (0)
#define PG8_LDB(dst, b, h) do { _Pragma("unroll") for (int n = 0; n < 2; ++n) _Pragma("unroll") for (int k = 0; k < 2; ++k) dst[n][k] = *(const PG8_LAS bf16x8*)(lds + PG8_SB(b, h) + boff + n * 2048 + k * 1024); } while (0)
#define PG8_MMA(ai, bj, At, Bt) do { __builtin_amdgcn_s_setprio(1); _Pragma("unroll") for (int m = 0; m < 4; ++m) _Pragma("unroll") for (int n = 0; n < 2; ++n) _Pragma("unroll") for (int k = 0; k < 2; ++k) \
        acc[ai][bj][m][n] = __builtin_amdgcn_mfma_f32_16x16x32_bf16(Bt[n][k], At[m][k], acc[ai][bj][m][n], 0, 0, 0); __builtin_amdgcn_s_setprio(0); } while (0)
#define PG8_WAIT_V(n) asm volatile("s_waitcnt vmcnt(" #n ")" ::: "memory")
#define PG8_WAIT_L(n) asm volatile("s_waitcnt lgkmcnt(" #n ")" ::: "memory")
#define PG8_BAR __builtin_amdgcn_s_barrier()
#define PG8_SCHED __builtin_amdgcn_sched_barrier(0)
    Unit cur, nxt; int ui = 0;
    if (!S.next(0, cur)) return;
    f32x4 acc[2][2][4][2];
#pragma unroll
    for (int a = 0; a < 2; ++a)
#pragma unroll
        for (int b = 0; b < 2; ++b)
#pragma unroll
            for (int m = 0; m < 4; ++m)
#pragma unroll
                for (int n = 0; n < 2; ++n) acc[a][b][m][n] = (f32x4){0.f, 0.f, 0.f, 0.f};
    bf16x8 At[4][2], B0[2][2], B1[2][2];
    const char* cA = (const char*)g.A + (size_t)cur.pm * tstep; const char* cB = (const char*)g.Bt + (size_t)cur.pn * tstep;
    S.a_ready(cur);
    if constexpr (SP2) {
        PG8_STAGE(PG8_SB(0, 0), cB, voffB); PG8_STAGE(PG8_SB(0, 1), cB + hstep, voffB); PG8_STAGE(PG8_SA(0, 0), cA, voffA); PG8_STAGE(PG8_SA(0, 1), cA + hstep, voffA);
        if (wr == 1) PG8_BAR;
        PG8_WAIT_V(2); PG8_BAR;
        PG8_STAGE(PG8_SB(1, 0), cB + kstep, voffB); PG8_STAGE(PG8_SA(1, 0), cA + kstep, voffA); PG8_STAGE(PG8_SB(1, 1), cB + hstep + kstep, voffB);
        PG8_WAIT_V(6); PG8_BAR;
    } else {
        PG8_STAGE(PG8_SB(0, 0), cB, voffB); PG8_STAGE(PG8_SA(0, 0), cA, voffA); PG8_STAGE(PG8_SB(0, 1), cB + hstep, voffB); PG8_STAGE(PG8_SA(0, 1), cA + hstep, voffA);
        if (wr == 1) PG8_BAR;
        PG8_WAIT_V(4); PG8_BAR;
        PG8_STAGE(PG8_SB(1, 0), cB + kstep, voffB); PG8_STAGE(PG8_SA(1, 0), cA + kstep, voffA); PG8_STAGE(PG8_SB(1, 1), cB + hstep + kstep, voffB);
        PG8_WAIT_V(6); PG8_BAR;
    }
    for (;;) {
        const bool has_next = S.next(ui + 1, nxt);
        const char* nA = has_next ? (const char*)g.A + (size_t)nxt.pm * tstep : cA; const char* nB = has_next ? (const char*)g.Bt + (size_t)nxt.pn * tstep : cB;
        for (int t = 0; t < nt; t += 2) {
            const bool last = (t == nt - 2);
            const char* a1 = cA + (size_t)(t + 1) * kstep;
            const char* a2 = last ? nA : cA + (size_t)(t + 2) * kstep; const char* b2 = last ? nB : cB + (size_t)(t + 2) * kstep;
            const char* a3 = a2 + kstep; const char* b3 = b2 + kstep;
            if (last && has_next) S.a_ready(nxt);
            if constexpr (SP2) {
            PG8_LDB(B0, 0, 0); PG8_LDB(B1, 0, 1); PG8_SCHED; PG8_LDA(At, 0, 0); PG8_STAGE(PG8_SA(1, 1), a1 + hstep, voffA);
            PG8_WAIT_V(8); PG8_WAIT_L(0); PG8_BAR; PG8_MMA(0, 0, At, B0); PG8_MMA(0, 1, At, B1); PG8_BAR; PG8_SCHED;
            PG8_LDA(At, 0, 1); PG8_STAGE(PG8_SB(0, 0), b2, voffB); PG8_STAGE(PG8_SB(0, 1), b2 + hstep, voffB); PG8_STAGE(PG8_SA(0, 0), a2, voffA);
            PG8_WAIT_V(8); PG8_WAIT_L(0); PG8_BAR; PG8_MMA(1, 0, At, B0); PG8_MMA(1, 1, At, B1); PG8_BAR; PG8_SCHED;
            PG8_LDB(B0, 1, 0); PG8_LDB(B1, 1, 1); PG8_SCHED; PG8_LDA(At, 1, 0); PG8_STAGE(PG8_SA(0, 1), a2 + hstep, voffA);
            PG8_WAIT_V(8); PG8_WAIT_L(0); PG8_BAR; PG8_MMA(0, 0, At, B0); PG8_MMA(0, 1, At, B1); PG8_BAR; PG8_SCHED;
            PG8_LDA(At, 1, 1); PG8_STAGE(PG8_SB(1, 0), b3, voffB); PG8_STAGE(PG8_SB(1, 1), b3 + hstep, voffB); PG8_STAGE(PG8_SA(1, 0), a3, voffA);
            PG8_WAIT_V(8); PG8_WAIT_L(0); PG8_BAR; PG8_MMA(1, 0, At, B0); PG8_MMA(1, 1, At, B1); PG8_BAR; PG8_SCHED;
            } else {
            PG8_LDB(B0, 0, 0); PG8_SCHED; PG8_LDA(At, 0, 0); PG8_STAGE(PG8_SA(1, 1), a1 + hstep, voffA);
            PG8_WAIT_L(8); PG8_BAR; PG8_WAIT_L(0); PG8_MMA(0, 0, At, B0); PG8_BAR; PG8_SCHED;
            PG8_LDB(B1, 0, 1); PG8_STAGE(PG8_SB(0, 0), b2, voffB);
            PG8_BAR; PG8_WAIT_L(0); PG8_MMA(0, 1, At, B1); PG8_BAR;
            PG8_LDA(At, 0, 1); PG8_STAGE(PG8_SA(0, 0), a2, voffA);
            PG8_BAR; PG8_WAIT_L(0); PG8_MMA(1, 0, At, B0); PG8_BAR; PG8_SCHED;
            PG8_STAGE(PG8_SB(0, 1), b2 + hstep, voffB);
            PG8_WAIT_V(6); PG8_BAR; PG8_MMA(1, 1, At, B1); PG8_BAR;
            PG8_LDB(B0, 1, 0); PG8_SCHED; PG8_LDA(At, 1, 0); PG8_STAGE(PG8_SA(0, 1), a2 + hstep, voffA);
            PG8_WAIT_L(8); PG8_BAR; PG8_WAIT_L(0); PG8_MMA(0, 0, At, B0); PG8_BAR; PG8_SCHED;
            PG8_LDB(B1, 1, 1); PG8_STAGE(PG8_SB(1, 0), b3, voffB);
            PG8_BAR; PG8_WAIT_L(0); PG8_MMA(0, 1, At, B1); PG8_BAR;
            PG8_LDA(At, 1, 1); PG8_STAGE(PG8_SA(1, 0), a3, voffA);
            PG8_BAR; PG8_WAIT_L(0); PG8_MMA(1, 0, At, B0); PG8_BAR; PG8_SCHED;
            PG8_STAGE(PG8_SB(1, 1), b3 + hstep, voffB);
            PG8_WAIT_V(6); PG8_BAR; PG8_MMA(1, 1, At, B1); PG8_BAR;
            }
        }
        if constexpr (ALIGN_EPI) { if (wr == 0) PG8_BAR; }
        if constexpr (!Epi::AFTER_DRAIN) { E(acc, cur, wr, wc, fr, fq); S.done(cur); }
        if (!has_next) break;
#pragma unroll
        for (int a = 0; a < 2; ++a)
#pragma unroll
            for (int b = 0; b < 2; ++b)
#pragma unroll
                for (int m = 0; m < 4; ++m)
#pragma unroll
                    for (int n = 0; n < 2; ++n) acc[a][b][m][n] = (f32x4){0.f, 0.f, 0.f, 0.f};
        cur = nxt; cA = nA; cB = nB; ++ui;
        if constexpr (ALIGN_EPI) { if (wr == 1) PG8_BAR; }
    }
    PG8_WAIT_V(0);
    if constexpr (!ALIGN_EPI) { if (wr == 0) PG8_BAR; }
    PG8_BAR;
    if constexpr (Epi::AFTER_DRAIN) { E.fused(acc, cur, wr, wc, fr, fq, lds, wid, lane); S.done(cur); }
#undef PG8_SA
#undef PG8_SB
#undef PG8_STAGE
#undef PG8_LDA
#undef PG8_LDB
#undef PG8_MMA
#undef PG8_WAIT_V
#undef PG8_WAIT_L
#undef PG8_BAR
#undef PG8_SCHED
}
}
constexpr int D = 1024, NB = 16, T = 4096, M = NB * T, DFF = 2816;
constexpr int PITCH = 4864;
constexpr int NIN_PAD = 5120;
constexpr int C_QN = 0, C_KC = 512, C_VC = 640, C_KS = 768, C_VS = 896, C_KW = 1024, C_VW = 1152, C_QF = 1280, C_KF = 1792, C_VF = 2304, C_GMN = 2816, C_GMF = 3840;
constexpr float LOG2E = 1.4426950408889634f;
constexpr float C2 = 0.125f * LOG2E;
#define LAS __attribute__((address_space(3)))
typedef float f32x16 __attribute__((ext_vector_type(16)));
typedef short s16x4 __attribute__((ext_vector_type(4)));
typedef float f32x2v __attribute__((ext_vector_type(2)));
typedef __bf16 bf16x2v __attribute__((ext_vector_type(2)));
__device__ __forceinline__ unsigned pk2(float lo, float hi) { f32x2v v = {lo, hi}; bf16x2v b = __builtin_convertvector(v, bf16x2v); return __builtin_bit_cast(unsigned, b); }
__device__ __forceinline__ float bflo(unsigned u) { return __uint_as_float(u << 16); }
__device__ __forceinline__ float bfhi(unsigned u) { return __uint_as_float(u & 0xffff0000u); }
__device__ __forceinline__ float bf2f(unsigned short u) { return __uint_as_float(((unsigned)u) << 16); }
__device__ __forceinline__ float sigmoidf_(float x) { return __builtin_amdgcn_rcpf(1.f + __builtin_amdgcn_exp2f(-x * LOG2E)); }

namespace pg8 {
struct EpiSwiglu {
    static constexpr bool PERM = true, AFTER_DRAIN = false;
    bf16_t* O;
    __device__ __forceinline__ void operator()(const f32x4 (&acc)[2][2][4][2], const Unit& u, int wr, int wc, int fr, int fq) const {
        const int row0 = u.pm * BM + wr * 64 + fr; const int col0 = u.pn * 128 + wc * 32 + 8 * fq;
#pragma unroll
        for (int ai = 0; ai < 2; ++ai)
#pragma unroll
            for (int m = 0; m < 4; ++m) {
                bf16_t* p = O + (size_t)(row0 + ai * HALF + m * 16) * DFF + col0;
                float a[8];
#pragma unroll
                for (int n = 0; n < 2; ++n)
#pragma unroll
                    for (int j = 0; j < 4; ++j) { const float g = acc[ai][0][m][n][j], up = acc[ai][1][m][n][j]; a[n * 4 + j] = g * sigmoidf_(g) * up; }
                u32x4 w; w.x = pk2(a[0], a[1]); w.y = pk2(a[2], a[3]); w.z = pk2(a[4], a[5]); w.w = pk2(a[6], a[7]);
                *(u32x4*)p = w;
            }
    }
};
struct EpiResid {
    static constexpr bool PERM = false, AFTER_DRAIN = false;
    const float* base; float* out; const float* gate; float s;
    __device__ __forceinline__ void operator()(const f32x4 (&acc)[2][2][4][2], const Unit& u, int wr, int wc, int fr, int fq) const {
        const int row0 = u.pm * BM + wr * 64 + fr; const int col0 = u.pn * BM + wc * 32 + 4 * fq;
        const int b = (u.pm * BM) >> 12;
#pragma unroll
        for (int bj = 0; bj < 2; ++bj)
#pragma unroll
            for (int n = 0; n < 2; ++n) {
                const int c = col0 + bj * HALF + n * 16;
                const f32x4 g4 = *(const f32x4*)(gate + (size_t)b * 9216 + c) * s;
#pragma unroll
                for (int ai = 0; ai < 2; ++ai)
#pragma unroll
                    for (int m = 0; m < 4; ++m) {
                        const size_t off = (size_t)(row0 + ai * HALF + m * 16) * D + c;
                        const f32x4 bs = *(const f32x4*)(base + off);
                        *(f32x4*)(out + off) = bs + g4 * acc[ai][bj][m][n];
                    }
            }
    }
};
struct EpiProj {
    static constexpr bool PERM = true, AFTER_DRAIN = false;
    bf16_t* P; float* small; float* flogT;
    __device__ __forceinline__ void operator()(const f32x4 (&acc)[2][2][4][2], const Unit& u, int wr, int wc, int fr, int fq) const {
        const int row0 = u.pm * BM + wr * 64 + fr;
        if (u.pn < 19) {
            const float sc = (u.pn < 2 || u.pn == 5 || u.pn == 6) ? C2 : 1.f;
            const int col0 = u.pn * BM + wc * 32 + 8 * fq;
#pragma unroll
            for (int ai = 0; ai < 2; ++ai)
#pragma unroll
                for (int m = 0; m < 4; ++m) {
                    bf16_t* rowp = P + (size_t)(row0 + ai * HALF + m * 16) * PITCH + col0;
#pragma unroll
                    for (int bj = 0; bj < 2; ++bj) {
                        const f32x4 v0 = acc[ai][bj][m][0] * sc, v1 = acc[ai][bj][m][1] * sc;
                        u32x4 w; w.x = pk2(v0[0], v0[1]); w.y = pk2(v0[2], v0[3]); w.z = pk2(v1[0], v1[1]); w.w = pk2(v1[2], v1[3]);
                        *(u32x4*)(rowp + bj * HALF) = w;
                    }
                }
        } else if (wc == 0) {
#pragma unroll
            for (int ai = 0; ai < 2; ++ai)
#pragma unroll
                for (int m = 0; m < 4; ++m) {
                    const int row = row0 + ai * HALF + m * 16;
                    float* sp = small + (size_t)row * 32 + 8 * fq;
                    *(f32x4*)sp = acc[ai][0][m][0]; *(f32x4*)(sp + 4) = acc[ai][0][m][1];
                    if (fq == 3) {
#pragma unroll
                        for (int j = 0; j < 4; ++j) { flogT[(size_t)j * M + row] = acc[ai][0][m][0][j]; flogT[(size_t)(4 + j) * M + row] = acc[ai][0][m][1][j]; } }
                }
        }
    }
};
template <bool ADD> struct EpiGate {
    static constexpr bool PERM = true, AFTER_DRAIN = false;
    const bf16_t* proj; int gcol; bf16_t* O;
    __device__ __forceinline__ void operator()(const f32x4 (&acc)[2][2][4][2], const Unit& u, int wr, int wc, int fr, int fq) const {
        const int row0 = u.pm * BM + wr * 64 + fr; const int col0 = u.pn * BM + wc * 32 + 8 * fq;
#pragma unroll
        for (int ai = 0; ai < 2; ++ai)
#pragma unroll
            for (int m = 0; m < 4; ++m) {
                const size_t row = (size_t)(row0 + ai * HALF + m * 16);
#pragma unroll
                for (int bj = 0; bj < 2; ++bj) {
                    const int c = col0 + bj * HALF;
                    const u32x4 gm = *(const u32x4*)(proj + row * PITCH + gcol + c);
                    bf16_t* op = O + row * D + c;
                    float v[8];
                    v[0] = sigmoidf_(bflo(gm.x)) * acc[ai][bj][m][0][0]; v[1] = sigmoidf_(bfhi(gm.x)) * acc[ai][bj][m][0][1];
                    v[2] = sigmoidf_(bflo(gm.y)) * acc[ai][bj][m][0][2]; v[3] = sigmoidf_(bfhi(gm.y)) * acc[ai][bj][m][0][3];
                    v[4] = sigmoidf_(bflo(gm.z)) * acc[ai][bj][m][1][0]; v[5] = sigmoidf_(bfhi(gm.z)) * acc[ai][bj][m][1][1];
                    v[6] = sigmoidf_(bflo(gm.w)) * acc[ai][bj][m][1][2]; v[7] = sigmoidf_(bfhi(gm.w)) * acc[ai][bj][m][1][3];
                    if (ADD) { const u32x4 pv = *(const u32x4*)op;
                        v[0] += bflo(pv.x); v[1] += bfhi(pv.x); v[2] += bflo(pv.y); v[3] += bfhi(pv.y); v[4] += bflo(pv.z); v[5] += bfhi(pv.z); v[6] += bflo(pv.w); v[7] += bfhi(pv.w); }
                    u32x4 w; w.x = pk2(v[0], v[1]); w.y = pk2(v[2], v[3]); w.z = pk2(v[4], v[5]); w.w = pk2(v[6], v[7]);
                    *(u32x4*)op = w;
                }
            }
    }
};
struct EpiGelu {
    static constexpr bool PERM = true, AFTER_DRAIN = false;
    bf16_t* O;
    __device__ __forceinline__ static float gelu(float x) { const float uu = 0.7978845608028654f * (x + 0.044715f * x * x * x); return x * sigmoidf_(2.f * uu); }
    __device__ __forceinline__ void operator()(const f32x4 (&acc)[2][2][4][2], const Unit& u, int wr, int wc, int fr, int fq) const {
        const int row0 = u.pm * BM + wr * 64 + fr; const int col0 = u.pn * BM + wc * 32 + 8 * fq;
#pragma unroll
        for (int ai = 0; ai < 2; ++ai)
#pragma unroll
            for (int m = 0; m < 4; ++m) {
                bf16_t* rowp = O + (size_t)(row0 + ai * HALF + m * 16) * 256 + col0;
#pragma unroll
                for (int bj = 0; bj < 2; ++bj) {
                    const f32x4 v0 = acc[ai][bj][m][0], v1 = acc[ai][bj][m][1];
                    u32x4 w; w.x = pk2(gelu(v0[0]), gelu(v0[1])); w.y = pk2(gelu(v0[2]), gelu(v0[3])); w.z = pk2(gelu(v1[0]), gelu(v1[1])); w.w = pk2(gelu(v1[2]), gelu(v1[3]));
                    *(u32x4*)(rowp + bj * HALF) = w;
                }
            }
    }
};
}
using pg8::bf16_t; using pg8::bf16x8; using pg8::f32x4; using pg8::u32x4;
#define XB_TMO      128
#define XB_XCNT(j)  (256  + 64 * (j))
#define XB_XSUB(j)  (1280 + 64 * (j))
#define XB_XGEN(j)  (2304 + 64 * (j))
#define XB_TOP      3328
#define XB_TOPGEN   3392
#define XCD_BAR_WORDS 3456
#define XB_SPIN_CAP (1u << 18)

__device__ __forceinline__ unsigned xb_ld(unsigned* p)              { return __hip_atomic_load(p, __ATOMIC_RELAXED, __HIP_MEMORY_SCOPE_AGENT); }
__device__ __forceinline__ unsigned xb_add(unsigned* p, unsigned v) { return __hip_atomic_fetch_add(p, v, __ATOMIC_RELAXED, __HIP_MEMORY_SCOPE_AGENT); }
__device__ __forceinline__ unsigned xb_xcc_id() { return (unsigned)__builtin_amdgcn_s_getreg((3 << 11) | 20) & 0xFu; }
#define XB_SPIN(cond, bar) do { unsigned _sp = 0; while (cond) { __builtin_amdgcn_s_sleep(1); \
    if ((++_sp & 255u) == 0u) { if (xb_ld(&(bar)[XB_TMO])) break; if (_sp > XB_SPIN_CAP) { atomicAdd(&(bar)[XB_TMO], 1u); break; } } } } while (0)

struct XcdBarrier {
    unsigned* bar; unsigned x;
    volatile LAS unsigned* st;
};

__device__ __forceinline__ XcdBarrier xcd_barrier_post(unsigned* bar, volatile LAS unsigned* st) {
    XcdBarrier b; b.bar = bar; b.x = xb_xcc_id(); b.st = st;
    if (threadIdx.x == 0) (void)xb_add(&bar[XB_XCNT(b.x)], 1u);
    return b;
}
__device__ __forceinline__ void xcd_barrier_complete(unsigned* bar, unsigned x, unsigned& nloc, unsigned& nx) {
    const unsigned G = gridDim.x * gridDim.y * gridDim.z;
    unsigned sum, cnt, mine, sp = 0u;
    for (;;) {
        sum = 0u; cnt = 0u; mine = 0u;
#pragma unroll
        for (unsigned j = 0; j < 16; ++j) { const unsigned c = xb_ld(&bar[XB_XCNT(j)]); sum += c; cnt += (c > 0u) ? 1u : 0u; mine = (j == x) ? c : mine; }
        if (sum == G) break;
        __builtin_amdgcn_s_sleep(1);
        if ((++sp & 255u) == 0u) { if (xb_ld(&bar[XB_TMO])) break; if (sp > XB_SPIN_CAP) { atomicAdd(&bar[XB_TMO], 1u); break; } }
    }
    nloc = mine > 0u ? mine : 1u; nx = cnt > 0u ? cnt : 1u;
}

__device__ __forceinline__ void xcd_barrier(const XcdBarrier& b) {
    asm volatile("s_waitcnt vmcnt(0)" ::: "memory");
    __syncthreads();
    if (threadIdx.x == 0) {
        unsigned* bar = b.bar;
        __builtin_amdgcn_s_waitcnt(0);
        unsigned nloc = b.st[0], nx = b.st[1];
        if (nloc == 0u) { xcd_barrier_complete(bar, b.x, nloc, nx); b.st[0] = nloc; b.st[1] = nx; }
        const unsigned old = xb_add(&bar[XB_XSUB(b.x)], 1u);
        const unsigned gen = old / nloc;
        if (old + 1u == (gen + 1u) * nloc) {
            __builtin_amdgcn_fence(__ATOMIC_RELEASE, "agent");
            asm volatile("s_waitcnt vmcnt(0)" ::: "memory");
            const unsigned og = xb_add(&bar[XB_TOP], 1u);
            const unsigned tg = og / nx;
            if (og + 1u == (tg + 1u) * nx) xb_add(&bar[XB_TOPGEN], 1u);
            else XB_SPIN(xb_ld(&bar[XB_TOPGEN]) == tg, bar);
            __builtin_amdgcn_fence(__ATOMIC_ACQUIRE, "agent");
            xb_add(&bar[XB_XGEN(b.x)], 1u);
            asm volatile("s_waitcnt vmcnt(0)" ::: "memory");
        } else {
            XB_SPIN(xb_ld(&bar[XB_XGEN(b.x)]) == gen, bar);
            __builtin_amdgcn_fence(__ATOMIC_ACQUIRE, "agent");
            asm volatile("s_waitcnt vmcnt(0)" ::: "memory");
        }
    }
    __syncthreads();
}
namespace att {
constexpr int KROW = 144;
constexpr int VROW = 192;
constexpr int KTILEB = 64 * KROW, VTILEB = 64 * VROW;
constexpr int L_K = 0, L_V = 2 * KTILEB, L_SEL = L_V + 2 * VTILEB, L_UNI = L_SEL + 512, L_IMP = 45056;
static_assert(L_UNI + 16 <= L_IMP, "attention LDS map");
typedef short v4i16_t __attribute__((ext_vector_type(4)));
__device__ __forceinline__ int crow(int i, int h) { return (i & 3) + 8 * (i >> 2) + 4 * h; }
__device__ __forceinline__ s16x4 vtr(const LAS char* p) { return __builtin_bit_cast(s16x4, __builtin_amdgcn_ds_read_tr16_b64_v4i16((LAS v4i16_t*)p)); }
#define MFMA32(a, b, c) __builtin_amdgcn_mfma_f32_32x32x16_bf16((a), (b), (c), 0, 0, 0)
__device__ __forceinline__ float max3f(float a, float b, float c) { float r; asm("v_max3_f32 %0, %1, %2, %3" : "=v"(r) : "v"(a), "v"(b), "v"(c)); return r; }
__device__ __forceinline__ float fadd_s(float a, float b) { float r; asm("v_add_f32_e32 %0, %1, %2" : "=v"(r) : "v"(a), "v"(b)); return r; }

template <bool BIAS>
__device__ __forceinline__ void tile_scores(const LAS char* Kb, const bf16x8 (&qf)[4], const bf16x8& qaug, const f32x16& negm, f32x16& p0, f32x16& p1,
                                            int key0, int lo, int hi, bool on, int lane) {
    const int r32 = lane & 31, h = lane >> 5;
    const LAS char* kp = Kb + r32 * KROW + h * 16;
    { const bf16x8 k0 = *(const LAS bf16x8*)(kp), k1 = *(const LAS bf16x8*)(kp + 32 * KROW);
      p0 = MFMA32(k0, qf[0], negm); p1 = MFMA32(k1, qf[0], negm); }
#pragma unroll
    for (int d0 = 1; d0 < 4; ++d0) {
        const bf16x8 k0 = *(const LAS bf16x8*)(kp + d0 * 32);
        const bf16x8 k1 = *(const LAS bf16x8*)(kp + 32 * KROW + d0 * 32);
        p0 = MFMA32(k0, qf[d0], p0); p1 = MFMA32(k1, qf[d0], p1);
    }
    if (BIAS) {
        const LAS char* ka = Kb + r32 * KROW + 128;
        const bf16x8 k0 = *(const LAS bf16x8*)(ka), k1 = *(const LAS bf16x8*)(ka + 32 * KROW);
        p0 = MFMA32(k0, qaug, p0); p1 = MFMA32(k1, qaug, p1);
    }
    const bool full = on && (key0 >= lo) && (key0 + 63 <= hi);
    if (!__all(full)) {
#pragma unroll
        for (int i = 0; i < 16; ++i) {
            const int k = key0 + crow(i, h);
            if (!(on && k >= lo && k <= hi)) p0[i] = -INFINITY;
            if (!(on && k + 32 >= lo && k + 32 <= hi)) p1[i] = -INFINITY;
        }
    }
}

__device__ __forceinline__ void apply_mask(f32x16& p0, f32x16& p1, int key0, int lo, int hi, bool on, int lane) {
    const int h = lane >> 5;
    const bool inrange = (key0 >= lo) && (key0 + 63 <= hi);
    if (__all(inrange)) {
        if (!__all(on)) {
#pragma unroll
            for (int i = 0; i < 16; ++i) { p0[i] = on ? p0[i] : -INFINITY; p1[i] = on ? p1[i] : -INFINITY; }
        }
    } else {
#pragma unroll
        for (int i = 0; i < 16; ++i) {
            const int k = key0 + crow(i, h);
            if (!(on && k >= lo && k <= hi)) p0[i] = -INFINITY;
            if (!(on && k + 32 >= lo && k + 32 <= hi)) p1[i] = -INFINITY;
        }
    }
}
struct Soft { float mhat, l; bool started; };

template <bool BIAS>
__device__ __forceinline__ void tile_compute(const LAS char* Kb, const LAS char* Vb, const bf16x8 (&qf)[4], const bf16x8& qaug,
                                             f32x16& o0, f32x16& o1, f32x16& negm, Soft& st, int key0, int lo, int hi, bool on, int lane) {
    const int r32 = lane & 31, h = lane >> 5;
    constexpr int NK = BIAS ? 5 : 4;
    bf16x8 ka[NK], kb[NK];
    { const LAS char* kp = Kb + r32 * KROW + h * 16;
#pragma unroll
      for (int d0 = 0; d0 < 4; ++d0) { ka[d0] = *(const LAS bf16x8*)(kp + d0 * 32); kb[d0] = *(const LAS bf16x8*)(kp + 32 * KROW + d0 * 32); }
      if (BIAS) { const LAS char* kq = Kb + r32 * KROW + 128; ka[NK - 1] = *(const LAS bf16x8*)(kq); kb[NK - 1] = *(const LAS bf16x8*)(kq + 32 * KROW); } }
    __builtin_amdgcn_sched_barrier(0);
    f32x16 p0, p1;
    __builtin_amdgcn_s_setprio(1);
    p0 = MFMA32(ka[0], qf[0], negm); p1 = MFMA32(kb[0], qf[0], negm);
#pragma unroll
    for (int d0 = 1; d0 < 4; ++d0) { p0 = MFMA32(ka[d0], qf[d0], p0); p1 = MFMA32(kb[d0], qf[d0], p1); }
#ifdef PROBE_MFMA2
    { bf16x8 zq; for (int e = 0; e < 8; ++e) zq[e] = 0; asm volatile("" : "+v"(zq));
#pragma unroll
      for (int d0 = 0; d0 < 4; ++d0) { p0 = MFMA32(ka[d0], zq, p0); p1 = MFMA32(kb[d0], zq, p1); } }
#endif
    if (BIAS) { p0 = MFMA32(ka[NK - 1], qaug, p0); p1 = MFMA32(kb[NK - 1], qaug, p1); }
    __builtin_amdgcn_s_setprio(0);
    bf16x8 v0[4], v1[4];
    { const int i16 = lane & 15, q = i16 >> 2, pp = i16 & 3, blk = (lane >> 4) & 1;
      const LAS char* vp = Vb + (4 * h + q) * VROW + (16 * blk + 4 * pp) * 2;
#pragma unroll
      for (int ks = 0; ks < 4; ++ks) {
          const LAS char* a = vp + (16 * ks) * VROW;
          const s16x4 l0 = vtr(a), h0 = vtr(a + 8 * VROW), l1 = vtr(a + 64), h1 = vtr(a + 8 * VROW + 64);
          v0[ks] = __builtin_shufflevector(l0, h0, 0, 1, 2, 3, 4, 5, 6, 7); v1[ks] = __builtin_shufflevector(l1, h1, 0, 1, 2, 3, 4, 5, 6, 7);
      } }
    __builtin_amdgcn_sched_barrier(0);
    apply_mask(p0, p1, key0, lo, hi, on, lane);
    asm volatile("s_nop 15\n\ts_nop 7" : "+v"(p0), "+v"(p1));
    float mx;
    { float a = max3f(p0[0], p0[1], p1[0]), b = max3f(p0[2], p0[3], p1[1]); a = max3f(a, p1[2], p1[3]);
#pragma unroll
      for (int r = 4; r < 16; r += 4) { a = max3f(a, p0[r], p0[r + 1]); b = max3f(b, p0[r + 2], p0[r + 3]); a = max3f(a, p1[r], p1[r + 1]); b = max3f(b, p1[r + 2], p1[r + 3]); }
      mx = fmaxf(a, b); }
    { auto rr_ = __builtin_amdgcn_permlane32_swap(__float_as_uint(mx), __float_as_uint(mx), false, false); mx = fmaxf(__uint_as_float(rr_[0]), __uint_as_float(rr_[1])); }
    const bool need = st.started ? (mx > 6.f) : true;
    if (__any(need)) {
        float dl, f;
        if (!st.started) { const bool fin = mx > -INFINITY; dl = fin ? mx : 0.f; f = 1.f; st.started = fin; }
        else { dl = fmaxf(mx, 0.f); f = __builtin_amdgcn_exp2f(-dl); }
        st.mhat += dl;
#pragma unroll
        for (int i = 0; i < 16; ++i) { p0[i] -= dl; p1[i] -= dl; }
        st.l *= f;
#pragma unroll
        for (int i = 0; i < 16; ++i) { o0[i] *= f; o1[i] *= f; }
        const float nm = -st.mhat;
#pragma unroll
        for (int i = 0; i < 16; ++i) negm[i] = nm;
    }
#pragma unroll
    for (int i = 0; i < 16; ++i) { p0[i] = __builtin_amdgcn_exp2f(p0[i]); p1[i] = __builtin_amdgcn_exp2f(p1[i]); }
    asm volatile("s_nop 1" : "+v"(p0), "+v"(p1));
    { float sa = fadd_s(p0[0], p1[0]), sb = fadd_s(p0[1], p1[1]), sc_ = fadd_s(p0[2], p1[2]), sd = fadd_s(p0[3], p1[3]);
#pragma unroll
      for (int i = 4; i < 16; i += 4) { sa = fadd_s(sa, p0[i]); sb = fadd_s(sb, p0[i + 1]); sc_ = fadd_s(sc_, p0[i + 2]); sd = fadd_s(sd, p0[i + 3]);
                                        sa = fadd_s(sa, p1[i]); sb = fadd_s(sb, p1[i + 1]); sc_ = fadd_s(sc_, p1[i + 2]); sd = fadd_s(sd, p1[i + 3]); }
      st.l += fadd_s(fadd_s(sa, sb), fadd_s(sc_, sd)); }
    bf16x8 pa[4];
    { u32x4 w;
      w.x = pk2(p0[0], p0[1]); w.y = pk2(p0[2], p0[3]); w.z = pk2(p0[4], p0[5]); w.w = pk2(p0[6], p0[7]); pa[0] = __builtin_bit_cast(bf16x8, w);
      w.x = pk2(p0[8], p0[9]); w.y = pk2(p0[10], p0[11]); w.z = pk2(p0[12], p0[13]); w.w = pk2(p0[14], p0[15]); pa[1] = __builtin_bit_cast(bf16x8, w);
      w.x = pk2(p1[0], p1[1]); w.y = pk2(p1[2], p1[3]); w.z = pk2(p1[4], p1[5]); w.w = pk2(p1[6], p1[7]); pa[2] = __builtin_bit_cast(bf16x8, w);
      w.x = pk2(p1[8], p1[9]); w.y = pk2(p1[10], p1[11]); w.z = pk2(p1[12], p1[13]); w.w = pk2(p1[14], p1[15]); pa[3] = __builtin_bit_cast(bf16x8, w); }
    __builtin_amdgcn_sched_barrier(0);
    __builtin_amdgcn_s_setprio(1);
#pragma unroll
    for (int ks = 0; ks < 4; ++ks) { o0 = MFMA32(v0[ks], pa[ks], o0); o1 = MFMA32(v1[ks], pa[ks], o1); }
#ifdef PROBE_MFMA2
    { bf16x8 zq; for (int e = 0; e < 8; ++e) zq[e] = 0; asm volatile("" : "+v"(zq));
#pragma unroll
      for (int ks = 0; ks < 4; ++ks) { o0 = MFMA32(v0[ks], zq, o0); o1 = MFMA32(v1[ks], zq, o1); } }
#endif
    __builtin_amdgcn_s_setprio(0);
}

template <bool BIAS, bool REV>
__device__ __forceinline__ void run_pass(LAS char* lds, const bf16_t* Kg, const bf16_t* Vg, int pitch, const float* cfg, unsigned long long tiles,
                                         const bf16x8 (&qf)[4], const bf16x8& qaug, f32x16& o0, f32x16& o1, f32x16& negm, Soft& st,
                                         int lo, int hi, unsigned long long selbits, int wmaxkey, int tid, int lane) {
    if (!tiles) return;
    const int row = tid >> 3, ch = tid & 7;
    const size_t goff = (size_t)row * pitch + ch * 8;
    const int koff = row * KROW + ch * 16, voff = row * VROW + ch * 16;
#define ATT_NEXT(dst_) do { dst_ = -1; if (tiles) { dst_ = REV ? 63 - __builtin_clzll(tiles) : __builtin_ctzll(tiles); tiles &= ~(1ull << dst_); } } while (0)
#define ATT_GLOAD(kr_, vr_, cr_, t_) do { kr_ = *(const u32x4*)(Kg + (size_t)(t_) * 64 * pitch + goff); vr_ = *(const u32x4*)(Vg + (size_t)(t_) * 64 * pitch + goff); \
        if (BIAS && tid < 64) cr_ = cfg[(t_) * 64 + tid]; } while (0)
#define ATT_LWRITE(kr_, vr_, cr_, b_) do { *(LAS u32x4*)(lds + L_K + (b_) * KTILEB + koff) = kr_; *(LAS u32x4*)(lds + L_V + (b_) * VTILEB + voff) = vr_; \
        if (BIAS && tid < 64) { const float x_ = -cr_; const unsigned h_ = pk2(x_, 0.f) & 0xffffu; const float r1_ = x_ - bflo(h_); \
        const unsigned m_ = pk2(r1_, 0.f) & 0xffffu; const float r2_ = r1_ - bflo(m_); const unsigned l_ = pk2(r2_, 0.f) & 0xffffu; \
        *(LAS u32x4*)(lds + L_K + (b_) * KTILEB + tid * KROW + 128) = (u32x4){h_ | (m_ << 16), l_, 0u, 0u}; } } while (0)
#define ATT_COMPUTE(t_, b_) do { if ((t_) * 64 <= wmaxkey) tile_compute<BIAS>(lds + L_K + (b_) * KTILEB, lds + L_V + (b_) * VTILEB, qf, qaug, o0, o1, negm, st, (t_) * 64, lo, hi, ((selbits >> (t_)) & 1ull) != 0ull, lane); } while (0)
    int t0, t1, t2;
    u32x4 krA, vrA, krB, vrB; float crA = 0.f, crB = 0.f;
    ATT_NEXT(t0); ATT_NEXT(t1);
    ATT_GLOAD(krA, vrA, crA, t0);
    if (t1 >= 0) ATT_GLOAD(krB, vrB, crB, t1);
    ATT_LWRITE(krA, vrA, crA, 0);
    __syncthreads();
    for (;;) {
        ATT_NEXT(t2);
        if (t2 >= 0) ATT_GLOAD(krA, vrA, crA, t2);
        ATT_COMPUTE(t0, 0);
        if (t1 < 0) break;
        ATT_LWRITE(krB, vrB, crB, 1);
        __syncthreads();
        ATT_NEXT(t0);
        if (t0 >= 0) ATT_GLOAD(krB, vrB, crB, t0);
        ATT_COMPUTE(t1, 1);
        if (t2 < 0) break;
        ATT_LWRITE(krA, vrA, crA, 0);
        __syncthreads();
        t1 = t0; t0 = t2;
    }
    __syncthreads();
#undef ATT_NEXT
#undef ATT_GLOAD
#undef ATT_LWRITE
#undef ATT_COMPUTE
}

constexpr int L_K2 = 0, L_V2 = 4 * KTILEB;
static_assert(L_V2 + 4 * VTILEB <= 131072, "FoX pair buffers");
__device__ __forceinline__ void run_pass_fox2(LAS char* lds, const bf16_t* Kg, const bf16_t* Vg, int pitch, const float* cfg, int ntl,
                                              const bf16x8 (&qf)[4], const bf16x8& qaug, f32x16& o0, f32x16& o1, f32x16& negm, Soft& st,
                                              int hi, int wmaxkey, int tid, int lane) {
    const int row = tid >> 3, ch = tid & 7;
    const size_t goff = (size_t)row * pitch + ch * 8;
    const int koff = row * KROW + ch * 16, voff = row * VROW + ch * 16;
#define F2_GLOAD(i_, t_) do { kr[i_] = *(const u32x4*)(Kg + (size_t)(t_) * 64 * pitch + goff); vr[i_] = *(const u32x4*)(Vg + (size_t)(t_) * 64 * pitch + goff); \
        if (tid < 64) cr[i_] = cfg[(t_) * 64 + tid]; } while (0)
#define F2_LWRITE(i_, b_) do { *(LAS u32x4*)(lds + L_K2 + (2 * (b_) + (i_)) * KTILEB + koff) = kr[i_]; *(LAS u32x4*)(lds + L_V2 + (2 * (b_) + (i_)) * VTILEB + voff) = vr[i_]; \
        if (tid < 64) { const float x_ = -cr[i_]; const unsigned h_ = pk2(x_, 0.f) & 0xffffu; const float r1_ = x_ - bflo(h_); \
        const unsigned m_ = pk2(r1_, 0.f) & 0xffffu; const float r2_ = r1_ - bflo(m_); const unsigned l_ = pk2(r2_, 0.f) & 0xffffu; \
        *(LAS u32x4*)(lds + L_K2 + (2 * (b_) + (i_)) * KTILEB + tid * KROW + 128) = (u32x4){h_ | (m_ << 16), l_, 0u, 0u}; } } while (0)
#define F2_COMPUTE(t_, i_, b_) do { if ((t_) * 64 <= wmaxkey) tile_compute<true>(lds + L_K2 + (2 * (b_) + (i_)) * KTILEB, lds + L_V2 + (2 * (b_) + (i_)) * VTILEB, qf, qaug, o0, o1, negm, st, (t_) * 64, 0, hi, true, lane); } while (0)
    u32x4 kr[2], vr[2]; float cr[2] = {0.f, 0.f};
    int ta = ntl - 1;
    F2_GLOAD(0, ta); F2_GLOAD(1, ta - 1);
    F2_LWRITE(0, 0); F2_LWRITE(1, 0);
    __syncthreads();
    int b = 0;
    for (;;) {
        const int tn = ta - 2;
        if (tn >= 0) { F2_GLOAD(0, tn); F2_GLOAD(1, tn - 1); }
        F2_COMPUTE(ta, 0, b);
        F2_COMPUTE(ta - 1, 1, b);
        if (tn < 0) break;
        F2_LWRITE(0, b ^ 1); F2_LWRITE(1, b ^ 1);
        __syncthreads();
        b ^= 1; ta = tn;
    }
    __syncthreads();
#undef F2_GLOAD
#undef F2_LWRITE
#undef F2_COMPUTE
}

struct AttnArgs { const bf16_t* proj; const float* small; const float* cfl; const bf16_t* kc; const bf16_t* vc; bf16_t* onsa; bf16_t* ofox; };

__device__ __forceinline__ void load_q(bf16x8 (&qf)[4], const bf16_t* qrow, int h) {
#pragma unroll
    for (int d0 = 0; d0 < 4; ++d0) qf[d0] = *(const bf16x8*)(qrow + d0 * 16 + h * 8);
}
__device__ __forceinline__ void store_o(bf16_t* orow, const f32x16& o0, const f32x16& o1, int h) {
#pragma unroll
    for (int g = 0; g < 4; ++g) {
        unsigned long long w0 = (unsigned long long)pk2(o0[4 * g], o0[4 * g + 1]) | ((unsigned long long)pk2(o0[4 * g + 2], o0[4 * g + 3]) << 32);
        unsigned long long w1 = (unsigned long long)pk2(o1[4 * g], o1[4 * g + 1]) | ((unsigned long long)pk2(o1[4 * g + 2], o1[4 * g + 3]) << 32);
        *(unsigned long long*)(orow + 8 * g + 4 * h) = w0;
        *(unsigned long long*)(orow + 32 + 8 * g + 4 * h) = w1;
    }
}

__device__ __forceinline__ void fox_unit(LAS char* lds, const AttnArgs& A, int b, int hh, int qb, int tid) {
    const int lane = tid & 63, wave = __builtin_amdgcn_readfirstlane(tid >> 6), r32 = lane & 31, h = lane >> 5;
    const int q0 = qb * 256, tq = q0 + 32 * wave + r32;
    const size_t row = (size_t)b * T + tq;
    bf16x8 qf[4]; load_q(qf, A.proj + row * PITCH + C_QF + 64 * hh, h);
    f32x16 o0, o1, negm;
#pragma unroll
    for (int i = 0; i < 16; ++i) { o0[i] = 0.f; o1[i] = 0.f; negm[i] = 0.f; }
    Soft st{0.f, 0.f, false};
    bf16x8 qaug;
#pragma unroll
    for (int i = 0; i < 8; ++i) qaug[i] = (short)((h == 0 && i < 3) ? 0x3F80 : 0);
    const int ntl = 4 * qb + 4;
    const bf16_t* kb = A.proj + (size_t)b * T * PITCH + 64 * hh;
    run_pass_fox2(lds, kb + C_KF, kb + C_VF, PITCH, A.cfl + (size_t)(b * 8 + hh) * T, ntl, qf, qaug, o0, o1, negm, st, tq, q0 + 32 * wave + 31, tid, lane);
    float l = st.l;
    l += __shfl_xor(l, 32);
    const float inv = 1.f / l;
#pragma unroll
    for (int i = 0; i < 16; ++i) { o0[i] *= inv; o1[i] *= inv; }
    store_o(A.ofox + row * 512 + 64 * hh, o0, o1, h);
}

__device__ __forceinline__ void nsa_unit(LAS char* lds, const AttnArgs& A, int b, int g, int qb, int tid) {
    const int lane = tid & 63, wave = __builtin_amdgcn_readfirstlane(tid >> 6), r32 = lane & 31, h = lane >> 5;
    const int hl = wave >> 1, head = 4 * g + hl, tok = 32 * (wave & 1) + r32, tq = 64 * qb + tok;
    const size_t row = (size_t)b * T + tq;
    bf16x8 qf[4]; load_q(qf, A.proj + row * PITCH + C_QN + 64 * head, h);
    const float* gp = A.small + row * 32 + head * 3;
    const float g0 = sigmoidf_(gp[0]), g1 = sigmoidf_(gp[1]), g2 = sigmoidf_(gp[2]);
    f32x16 o0, o1, negm;
    LAS float* Tst = (LAS float*)(lds + L_IMP) + wave * 2048 + lane;
    bf16x8 qaug;
#pragma unroll
    for (int i = 0; i < 8; ++i) qaug[i] = 0;
#pragma unroll
    for (int i = 0; i < 16; ++i) { o0[i] = 0.f; o1[i] = 0.f; negm[i] = 0.f; }
    Soft st{0.f, 0.f, false};
    float l;
    const int ntc = ((4 * qb + 2) >> 6) + 1;
    const unsigned long long ctiles = (1ull << ntc) - 1ull;
    const int chi = (tq >= 31) ? ((tq - 31) >> 4) : -1;
    const bf16_t* kcb = A.kc + ((size_t)b * 512 + g) * 64; const bf16_t* vcb = A.vc + ((size_t)b * 512 + g) * 64;
    run_pass<false, false>(lds, kcb, vcb, 128, nullptr, ctiles, qf, qaug, o0, o1, negm, st, 0, chi, ~0ull, 0x7fffffff, tid, lane);
    l = st.l; l += __shfl_xor(l, 32);
    const float invl = (l > 0.f) ? 1.f / l : 0.f;
    const float scmp = g0 * invl;
    LAS unsigned long long* selp = (LAS unsigned long long*)(lds + L_SEL);
    LAS unsigned long long* unip = (LAS unsigned long long*)(lds + L_UNI);
    if (qb >= 16) {
        LAS float* imp = (LAS float*)(lds + L_IMP) + (hl * 64 + tok) * 64;
        float carry = 0.f;
        const int krow_ = tid >> 3, kch = tid & 7;
        { u32x4 kk[4];
#pragma unroll
          for (int kt = 0; kt < 4; ++kt) if (kt < ntc) kk[kt] = *(const u32x4*)(kcb + (size_t)(kt * 64 + krow_) * 128 + kch * 8);
#pragma unroll
          for (int kt = 0; kt < 4; ++kt) if (kt < ntc) *(LAS u32x4*)(lds + ((kt < 2) ? (L_K + kt * KTILEB) : (L_V + (kt - 2) * VTILEB)) + krow_ * KROW + kch * 16) = kk[kt]; }
        __syncthreads();
        for (int kt = 0; kt < ntc; ++kt) {
            f32x16 p0, p1;
            tile_scores<false>(lds + ((kt < 2) ? (L_K + kt * KTILEB) : (L_V + (kt - 2) * VTILEB)), qf, qaug, negm, p0, p1, kt * 64, 0, chi, true, lane);
#pragma unroll
            for (int half = 0; half < 2; ++half) {
                float s[4], e[4], pe[4];
#pragma unroll
                for (int gi = 0; gi < 4; ++gi) {
                    float a0, a1, a2, a3;
                    if (half == 0) { a0 = p0[4 * gi]; a1 = p0[4 * gi + 1]; a2 = p0[4 * gi + 2]; a3 = p0[4 * gi + 3]; }
                    else { a0 = p1[4 * gi]; a1 = p1[4 * gi + 1]; a2 = p1[4 * gi + 2]; a3 = p1[4 * gi + 3]; }
                    a0 = __builtin_amdgcn_exp2f(a0) * invl; a1 = __builtin_amdgcn_exp2f(a1) * invl; a2 = __builtin_amdgcn_exp2f(a2) * invl; a3 = __builtin_amdgcn_exp2f(a3) * invl;
                    s[gi] = (a0 + a1) + (a2 + a3); e[gi] = a3;
                }
#pragma unroll
                for (int gi = 0; gi < 4; ++gi) pe[gi] = __shfl_xor(e[gi], 32);
                const int nbase = kt * 16 + 8 * half;
#pragma unroll
                for (int gi = 0; gi < 4; ++gi) {
                    const float add = (h == 1) ? pe[gi] : (gi == 0 ? carry : pe[gi > 0 ? gi - 1 : 0]);
                    imp[nbase + 2 * gi + h] = s[gi] + add;
                }
                carry = pe[3];
            }
        }
        __syncthreads();
        const LAS float* impa = (const LAS float*)(lds + L_IMP);
        float vv[8]; int rk[8];
#pragma unroll
        for (int i = 0; i < 8; ++i) { const int tk = 8 * wave + i;
            vv[i] = ((impa[(0 * 64 + tk) * 64 + lane] + impa[(1 * 64 + tk) * 64 + lane]) + impa[(2 * 64 + tk) * 64 + lane]) + impa[(3 * 64 + tk) * 64 + lane]; rk[i] = 0; }
        for (int j = 1; j <= qb - 2; ++j) {
#pragma unroll
            for (int i = 0; i < 8; ++i) {
                const float vj = __uint_as_float((unsigned)__builtin_amdgcn_readlane((int)__float_as_uint(vv[i]), j));
                rk[i] += ((vj > vv[i]) || (vj == vv[i] && j < lane)) ? 1 : 0;
            }
        }
        const bool cand = (lane >= 1) && (lane <= qb - 2);
#pragma unroll
        for (int i = 0; i < 8; ++i) {
            const unsigned long long msk = __ballot(cand && rk[i] < 13) | 1ull | (1ull << qb) | (1ull << (qb - 1));
            if (lane == 0) selp[8 * wave + i] = msk;
        }
    } else {
        if (tid < 64) selp[tid] = (2ull << qb) - 1ull;
    }
    __syncthreads();
    if (wave == 0) {
        unsigned long long v = selp[lane];
        unsigned lo32 = (unsigned)v, hi32 = (unsigned)(v >> 32);
#pragma unroll
        for (int o = 1; o < 64; o <<= 1) { lo32 |= __shfl_xor(lo32, o); hi32 |= __shfl_xor(hi32, o); }
        if (lane == 0) unip[0] = ((unsigned long long)hi32 << 32) | lo32;
    }
    __syncthreads();
    const unsigned long long mysel = selp[tok];
    const unsigned long long uni = unip[0];
#pragma unroll
    for (int i = 0; i < 16; ++i) { Tst[i * 64] = o0[i] * scmp; Tst[(16 + i) * 64] = o1[i] * scmp; }
#pragma unroll
    for (int i = 0; i < 16; ++i) { o0[i] = 0.f; o1[i] = 0.f; negm[i] = 0.f; }
    st = Soft{0.f, 0.f, false};
    const bf16_t* pb = A.proj + (size_t)b * T * PITCH + 64 * g;
    run_pass<false, false>(lds, pb + C_KS, pb + C_VS, PITCH, nullptr, uni, qf, qaug, o0, o1, negm, st, 0, tq, mysel, 0x7fffffff, tid, lane);
    l = st.l; l += __shfl_xor(l, 32);
    { const float s = (l > 0.f) ? g1 / l : 0.f;
#pragma unroll
      for (int i = 0; i < 16; ++i) { Tst[i * 64] += o0[i] * s; Tst[(16 + i) * 64] += o1[i] * s; } }
#pragma unroll
    for (int i = 0; i < 16; ++i) { o0[i] = 0.f; o1[i] = 0.f; negm[i] = 0.f; }
    st = Soft{0.f, 0.f, false};
    const int w0 = (qb >= 8) ? qb - 8 : 0;
    const unsigned long long wtiles = ((qb >= 63) ? ~0ull : ((2ull << qb) - 1ull)) & ~((1ull << w0) - 1ull);
    run_pass<false, false>(lds, pb + C_KW, pb + C_VW, PITCH, nullptr, wtiles, qf, qaug, o0, o1, negm, st, tq - 511, tq, ~0ull, 0x7fffffff, tid, lane);
    l = st.l; l += __shfl_xor(l, 32);
    { const float s = (l > 0.f) ? g2 / l : 0.f;
#pragma unroll
      for (int i = 0; i < 16; ++i) { o0[i] = Tst[i * 64] + o0[i] * s; o1[i] = Tst[(16 + i) * 64] + o1[i] * s; } }
    store_o(A.onsa + row * 512 + 64 * head, o0, o1, h);
    __syncthreads();
}

__device__ __forceinline__ void attn_phase(LAS char* lds, const AttnArgs& A, unsigned* queue, int tid) {
    LAS unsigned* qs = (LAS unsigned*)(lds + 131072 + 128);
    int k = 0;
    for (;;) {
        const int q = (int)((xb_xcc_id() + (unsigned)k) & 7u);
        if (tid == 0) qs[0] = __hip_atomic_fetch_add(queue + 64 * q, 1u, __ATOMIC_RELAXED, __HIP_MEMORY_SCOPE_AGENT);
        __syncthreads();
        const unsigned u = qs[0];
        __syncthreads();
        if (u >= 512u) { if (++k == 8) break; continue; }
        const int s = (int)(u >> 5), w = (int)(u & 31u);
        if (w < 16) { const int pair = 4 * q + (w >> 2); nsa_unit(lds, A, pair >> 1, pair & 1, 63 - 4 * s - (w & 3), tid); }
        else { const int ww = w - 16; fox_unit(lds, A, 4 * (s & 3) + (ww >> 2), q, 15 - 4 * (s >> 2) - (ww & 3), tid); }
    }
}
}
constexpr size_t alignup(size_t x) { return (x + 4095) & ~(size_t)4095; }
constexpr size_t WS_CTL = 0, CTL_BYTES = 65536;
constexpr size_t WS_WGU1 = CTL_BYTES;
constexpr size_t WS_WD1 = WS_WGU1 + alignup((size_t)5632 * 1024 * 2);
constexpr size_t WS_WGU2 = WS_WD1 + alignup((size_t)1024 * 2816 * 2);
constexpr size_t WS_WD2 = WS_WGU2 + alignup((size_t)5632 * 1024 * 2);
constexpr size_t WS_WIN = WS_WD2 + alignup((size_t)1024 * 2816 * 2);
constexpr size_t WS_WUPN = WS_WIN + alignup((size_t)NIN_PAD * 1024 * 2);
constexpr size_t WS_WUPF = WS_WUPN + alignup((size_t)1024 * 512 * 2);
constexpr size_t WS_WO = WS_WUPF + alignup((size_t)1024 * 512 * 2);
constexpr size_t WS_WC = WS_WO + alignup((size_t)1024 * 1024 * 2);
constexpr size_t WS_MOD = WS_WC + alignup((size_t)256 * 2048 * 2);
constexpr size_t WS_CFL = WS_MOD + alignup((size_t)16 * 9216 * 4);
constexpr size_t WS_SMALL = WS_CFL + alignup((size_t)128 * 4096 * 4);
constexpr size_t WS_FLOGT = WS_SMALL + alignup((size_t)M * 32 * 4);
constexpr size_t WS_KC = WS_FLOGT + alignup((size_t)8 * M * 4);
constexpr size_t WS_VC = WS_KC + alignup((size_t)8192 * 64 * 2);
constexpr size_t WS_HID = WS_VC + alignup((size_t)8192 * 64 * 2);
constexpr size_t WS_ACMP = WS_HID + alignup((size_t)16384 * 256 * 2);
constexpr size_t WS_H = WS_ACMP + alignup((size_t)16384 * 2048 * 2);
constexpr size_t WS_ONSA = WS_H + alignup((size_t)M * 1024 * 2);
constexpr size_t WS_OFOX = WS_ONSA + alignup((size_t)M * 512 * 2);
constexpr size_t WS_BIG = WS_OFOX + alignup((size_t)M * 512 * 2);
constexpr size_t WS_END = WS_BIG + alignup((size_t)M * PITCH * 2);
static_assert(WS_END <= ((size_t)1 << 30), "workspace map exceeds 1 GiB");

constexpr int LDS_BYTES = 147456;

struct Params { const void* in[26]; float* out; unsigned char* ws; };

__device__ __forceinline__ float wave_sum(float v) {
#pragma unroll
    for (int o = 1; o < 64; o <<= 1) v += __shfl_xor(v, o);
    return v;
}

struct MapId { int off; __device__ __forceinline__ int operator()(int n) const { return n + off; } };
struct MapGU { int off; __device__ __forceinline__ int operator()(int n) const { return 256 * (n >> 7) + (n & 127) + off; } };
struct MapIn { __device__ __forceinline__ int operator()(int n) const {
    if (n < 1280) return n; if (n < 1304) return 4864 + (n - 1280); if (n < 2840) return n - 24; if (n < 2848) return 4864 + 24 + (n - 2840); return n - 32; } };
template <class RowMap>
__device__ __forceinline__ void transpose_item(const float* W, int K, int N, bf16_t* WT, const RowMap rm, LAS float* scr, int item, int lane) {
    const int nblk = N / 32, kb = item / nblk, nb = item % nblk, k0 = 64 * kb, n0 = 32 * nb;
#pragma unroll
    for (int i = 0; i < 8; ++i) { const int kk = 8 * i + (lane >> 3), c4 = 4 * (lane & 7);
        const f32x4 v = *(const f32x4*)(W + (size_t)(k0 + kk) * N + n0 + c4);
        LAS float* d = scr + kk * 33 + c4; d[0] = v.x; d[1] = v.y; d[2] = v.z; d[3] = v.w; }
    asm volatile("s_waitcnt lgkmcnt(0)" ::: "memory");
    const int c = lane & 7;
#pragma unroll
    for (int j = 0; j < 4; ++j) { const int n = (lane >> 3) + 8 * j; const LAS float* s = scr + (8 * c) * 33 + n;
        u32x4 o; o.x = pk2(s[0 * 33], s[1 * 33]); o.y = pk2(s[2 * 33], s[3 * 33]); o.z = pk2(s[4 * 33], s[5 * 33]); o.w = pk2(s[6 * 33], s[7 * 33]);
        *(u32x4*)(WT + (size_t)rm(n0 + n) * K + k0 + 8 * c) = o; }
    asm volatile("s_waitcnt lgkmcnt(0)" ::: "memory");
}

template <class PT> __device__ __forceinline__ void phase_weights(LAS char* lds, const PT& p, int tid) {
    const int lane = tid & 63, wave = tid >> 6;
    LAS float* scr = (LAS float*)(lds + wave * 8704);
    const int gw = blockIdx.x * 8 + wave, NGW = gridDim.x * 8;
    unsigned char* ws = p.ws;
    constexpr int I_G = 16 * 88, I_D = 44 * 32, I_IN = 16 * 153, I_UP = 8 * 32, I_O = 16 * 32, I_C = 32 * 4;
    constexpr int NITEMS = 4 * I_G + 2 * I_D + I_IN + 2 * I_UP + I_O + 2 * I_C;
    for (int it = gw; it < NITEMS; it += NGW) {
        int r = it;
        if (r < I_G) { transpose_item((const float*)p.in[6], 1024, DFF, (bf16_t*)(ws + WS_WGU1), MapGU{0}, scr, r, lane); continue; } r -= I_G;
        if (r < I_G) { transpose_item((const float*)p.in[7], 1024, DFF, (bf16_t*)(ws + WS_WGU1), MapGU{128}, scr, r, lane); continue; } r -= I_G;
        if (r < I_G) { transpose_item((const float*)p.in[22], 1024, DFF, (bf16_t*)(ws + WS_WGU2), MapGU{0}, scr, r, lane); continue; } r -= I_G;
        if (r < I_G) { transpose_item((const float*)p.in[23], 1024, DFF, (bf16_t*)(ws + WS_WGU2), MapGU{128}, scr, r, lane); continue; } r -= I_G;
        if (r < I_D) { transpose_item((const float*)p.in[8], DFF, 1024, (bf16_t*)(ws + WS_WD1), MapId{0}, scr, r, lane); continue; } r -= I_D;
        if (r < I_D) { transpose_item((const float*)p.in[24], DFF, 1024, (bf16_t*)(ws + WS_WD2), MapId{0}, scr, r, lane); continue; } r -= I_D;
        if (r < I_IN) { transpose_item((const float*)p.in[10], 1024, 4896, (bf16_t*)(ws + WS_WIN), MapIn{}, scr, r, lane); continue; } r -= I_IN;
        if (r < I_UP) { transpose_item((const float*)p.in[18], 512, 1024, (bf16_t*)(ws + WS_WUPN), MapId{0}, scr, r, lane); continue; } r -= I_UP;
        if (r < I_UP) { transpose_item((const float*)p.in[19], 512, 1024, (bf16_t*)(ws + WS_WUPF), MapId{0}, scr, r, lane); continue; } r -= I_UP;
        if (r < I_O) { transpose_item((const float*)p.in[20], 1024, 1024, (bf16_t*)(ws + WS_WO), MapId{0}, scr, r, lane); continue; } r -= I_O;
        if (r < I_C) { transpose_item((const float*)p.in[13], 2048, 128, (bf16_t*)(ws + WS_WC), MapId{0}, scr, r, lane); continue; } r -= I_C;
        transpose_item((const float*)p.in[16], 2048, 128, (bf16_t*)(ws + WS_WC), MapId{128}, scr, r, lane);
    }
    { u32x4* z = (u32x4*)(ws + WS_WIN + (size_t)4896 * 1024 * 2); const int nz = 224 * 1024 * 2 / 16;
      for (int i = blockIdx.x * 512 + tid; i < nz; i += gridDim.x * 512) z[i] = (u32x4){0u, 0u, 0u, 0u}; }
    __syncthreads();
    const float* c = (const float*)p.in[1]; const float* w_ada = (const float*)p.in[3]; const float* b_ada = (const float*)p.in[4];
    float* mod = (float*)(ws + WS_MOD);
    if (blockIdx.x < 144) {
        LAS float* sc = (LAS float*)lds;
        LAS float* red = (LAS float*)(lds + 65536);
        for (int i = tid; i < 16 * 1024; i += 512) { const int b = i >> 10, k = i & 1023; const float v = c[i]; sc[k * 16 + b] = v * sigmoidf_(v); }
        __syncthreads();
        for (int grp = blockIdx.x; grp < 144; grp += gridDim.x) {
            float acc[16];
#pragma unroll
            for (int b = 0; b < 16; ++b) acc[b] = 0.f;
            const int j = grp * 64 + lane;
            for (int k0 = wave * 128; k0 < wave * 128 + 128; k0 += 16) {
                float wv[16];
#pragma unroll
                for (int u = 0; u < 16; ++u) wv[u] = w_ada[(size_t)(k0 + u) * 9216 + j];
#pragma unroll
                for (int u = 0; u < 16; ++u) {
                    const int k = k0 + u;
                    const f32x4 s0 = *(const LAS f32x4*)(sc + k * 16), s1 = *(const LAS f32x4*)(sc + k * 16 + 4), s2 = *(const LAS f32x4*)(sc + k * 16 + 8), s3 = *(const LAS f32x4*)(sc + k * 16 + 12);
#pragma unroll
                    for (int q = 0; q < 4; ++q) { acc[q] += s0[q] * wv[u]; acc[4 + q] += s1[q] * wv[u]; acc[8 + q] += s2[q] * wv[u]; acc[12 + q] += s3[q] * wv[u]; }
                }
            }
#pragma unroll
            for (int b = 0; b < 16; ++b) red[(wave * 16 + b) * 64 + lane] = acc[b];
            __syncthreads();
            for (int o = tid; o < 1024; o += 512) { const int b = o >> 6, cc = o & 63; float s = 0.f;
#pragma unroll
                for (int w = 0; w < 8; ++w) s += red[(w * 16 + b) * 64 + cc];
                mod[(size_t)b * 9216 + grp * 64 + cc] = s + b_ada[grp * 64 + cc]; }
            __syncthreads();
        }
    }
}

__device__ __forceinline__ void phase_norm_mod(const float* X, const float* g, const float* mod, int sh_idx, int sc_idx, bf16_t* H, int tid) {
    const int lane = tid & 63, wave = tid >> 6;
    const int gw = blockIdx.x * 8 + wave, NGW = gridDim.x * 8;
    for (int mrow = gw; mrow < M; mrow += 2 * NGW) {
        const int mrow2 = (mrow + NGW < M) ? mrow + NGW : mrow;
        const f32x4* xr = (const f32x4*)(X + (size_t)mrow * D) + lane; const f32x4* xr2 = (const f32x4*)(X + (size_t)mrow2 * D) + lane;
        f32x4 v[4], w[4]; float ss = 0.f, ss2 = 0.f;
#pragma unroll
        for (int j = 0; j < 4; ++j) { v[j] = __builtin_nontemporal_load(xr + 64 * j); w[j] = __builtin_nontemporal_load(xr2 + 64 * j); }
#pragma unroll
        for (int j = 0; j < 4; ++j) { ss += (v[j].x * v[j].x + v[j].y * v[j].y) + (v[j].z * v[j].z + v[j].w * v[j].w); ss2 += (w[j].x * w[j].x + w[j].y * w[j].y) + (w[j].z * w[j].z + w[j].w * w[j].w); }
        const float rstd = 1.0f / sqrtf(wave_sum(ss) * (1.f / D) + 1e-6f), rstd2 = 1.0f / sqrtf(wave_sum(ss2) * (1.f / D) + 1e-6f);
        const int b = mrow >> 12, b2 = mrow2 >> 12;
        unsigned long long* o8 = (unsigned long long*)(H + (size_t)mrow * D) + lane; unsigned long long* o82 = (unsigned long long*)(H + (size_t)mrow2 * D) + lane;
#pragma unroll
        for (int j = 0; j < 4; ++j) {
            const int col = 4 * lane + 256 * j;
            const f32x4 gg = *(const f32x4*)(g + col);
            { const f32x4 sc = *(const f32x4*)(mod + (size_t)b * 9216 + sc_idx * 1024 + col), sh = *(const f32x4*)(mod + (size_t)b * 9216 + sh_idx * 1024 + col);
              const f32x4 y = (v[j] * rstd) * gg * (sc + 1.f) + sh;
              o8[64 * j] = (unsigned long long)pk2(y.x, y.y) | ((unsigned long long)pk2(y.z, y.w) << 32); }
            if (mrow2 != mrow) { const f32x4 sc = *(const f32x4*)(mod + (size_t)b2 * 9216 + sc_idx * 1024 + col), sh = *(const f32x4*)(mod + (size_t)b2 * 9216 + sh_idx * 1024 + col);
              const f32x4 y = (w[j] * rstd2) * gg * (sc + 1.f) + sh;
              o82[64 * j] = (unsigned long long)pk2(y.x, y.y) | ((unsigned long long)pk2(y.z, y.w) << 32); }
        }
    }
}
__device__ __forceinline__ void phase_final_norm(float* X, const float* g, int tid) {
    const int lane = tid & 63, wave = tid >> 6;
    const int gw = blockIdx.x * 8 + wave, NGW = gridDim.x * 8;
    for (int mrow = gw; mrow < M; mrow += 2 * NGW) {
        const int mrow2 = (mrow + NGW < M) ? mrow + NGW : mrow;
        f32x4* xr = (f32x4*)(X + (size_t)mrow * D) + lane; f32x4* xr2 = (f32x4*)(X + (size_t)mrow2 * D) + lane;
        f32x4 v[4], w[4]; float ss = 0.f, ss2 = 0.f;
#pragma unroll
        for (int j = 0; j < 4; ++j) { v[j] = __builtin_nontemporal_load(xr + 64 * j); w[j] = __builtin_nontemporal_load(xr2 + 64 * j); }
#pragma unroll
        for (int j = 0; j < 4; ++j) { ss += (v[j].x * v[j].x + v[j].y * v[j].y) + (v[j].z * v[j].z + v[j].w * v[j].w); ss2 += (w[j].x * w[j].x + w[j].y * w[j].y) + (w[j].z * w[j].z + w[j].w * w[j].w); }
        const float rstd = 1.0f / sqrtf(wave_sum(ss) * (1.f / D) + 1e-6f), rstd2 = 1.0f / sqrtf(wave_sum(ss2) * (1.f / D) + 1e-6f);
#pragma unroll
        for (int j = 0; j < 4; ++j) { const f32x4 gg = *(const f32x4*)(g + 4 * lane + 256 * j); __builtin_nontemporal_store((v[j] * rstd) * gg, xr + 64 * j); if (mrow2 != mrow) __builtin_nontemporal_store((w[j] * rstd2) * gg, xr2 + 64 * j); }
    }
}

__device__ __forceinline__ void rope_cs(int pos, float (&cs)[8], float (&sn)[8]) {
    const float fp = (float)pos;
#pragma unroll
    for (int i = 0; i < 8; ++i) {
        const float inv = powf(500000.0f, -(float)i / 8.0f);
        const float ang = fp * inv;
        const double rev = (double)ang * 0.15915494309189535;
        const float fr = (float)(rev - rint(rev));
        sn[i] = __builtin_amdgcn_sinf(fr); cs[i] = __builtin_amdgcn_cosf(fr);
    }
}
__device__ __forceinline__ void rope_apply(u32x4& a, u32x4& b, const float (&cs)[8], const float (&sn)[8]) {
    float x1[8] = {bflo(a.x), bfhi(a.x), bflo(a.y), bfhi(a.y), bflo(a.z), bfhi(a.z), bflo(a.w), bfhi(a.w)};
    float x2[8] = {bflo(b.x), bfhi(b.x), bflo(b.y), bfhi(b.y), bflo(b.z), bfhi(b.z), bflo(b.w), bfhi(b.w)};
    float r1[8], r2[8];
#pragma unroll
    for (int i = 0; i < 8; ++i) { r1[i] = x1[i] * cs[i] - x2[i] * sn[i]; r2[i] = x2[i] * cs[i] + x1[i] * sn[i]; }
    a.x = pk2(r1[0], r1[1]); a.y = pk2(r1[2], r1[3]); a.z = pk2(r1[4], r1[5]); a.w = pk2(r1[6], r1[7]);
    b.x = pk2(r2[0], r2[1]); b.y = pk2(r2[2], r2[3]); b.z = pk2(r2[4], r2[5]); b.w = pk2(r2[6], r2[7]);
}

template <int PART, class PT> __device__ __forceinline__ void phase_post(const PT& p, int tid, int vbx, int vG) {
    unsigned char* ws = p.ws;
    bf16_t* proj = (bf16_t*)(ws + WS_BIG);
    const int* positions = (const int*)p.in[2];
    const int lane = tid & 63, wave = tid >> 6;
    if (PART == 1) for (int mm = vbx * 512 + tid; mm < M; mm += vG * 512) {
        float cs[8], sn[8]; rope_cs(positions[mm], cs, sn);
        bf16_t* rowp = proj + (size_t)mm * PITCH;
#pragma unroll 1
        for (int slot = 0; slot < 12; ++slot) {
            const int cb = slot < 8 ? C_QN + 64 * slot : (slot < 10 ? C_KS + 64 * (slot - 8) : C_KW + 64 * (slot - 10));
            u32x4 a = *(const u32x4*)(rowp + cb), b = *(const u32x4*)(rowp + cb + 8);
            rope_apply(a, b, cs, sn);
            *(u32x4*)(rowp + cb) = a; *(u32x4*)(rowp + cb + 8) = b;
        }
    }
    if (PART == 2) {
        bf16_t* acmp = (bf16_t*)(ws + WS_ACMP);
        const float* pe_ck = (const float*)p.in[12]; const float* pe_cv = (const float*)p.in[15];
        const int gw = blockIdx.x * 8 + wave, NGW = gridDim.x * 8;
        const int j = lane >> 1, dh = lane & 1;
        for (int row = gw; row < 16384; row += NGW) {
            const int kv = row >> 13, rr = row & 8191, b = rr >> 9, c = (rr >> 1) & 255, g = rr & 1;
            u32x4* dst = (u32x4*)(acmp + (size_t)row * 2048 + j * 64 + dh * 32);
            if (c == 255) { const u32x4 z = {0u, 0u, 0u, 0u}; dst[0] = z; dst[1] = z; dst[2] = z; dst[3] = z; continue; }
            const int t = 16 * c + j;
            const size_t mm = (size_t)b * T + t;
            const bf16_t* src = proj + mm * PITCH + (kv ? C_VC : C_KC) + 64 * g + dh * 32;
            u32x4 x[4];
#pragma unroll
            for (int q = 0; q < 4; ++q) x[q] = *(const u32x4*)(src + 8 * q);
            if (kv == 0 && dh == 0) { float cs[8], sn[8]; rope_cs(positions[mm], cs, sn); rope_apply(x[0], x[1], cs, sn); }
            const float* pe = (kv ? pe_cv : pe_ck) + j * 64 + dh * 32;
#pragma unroll
            for (int q = 0; q < 4; ++q) {
                const f32x4 e0 = *(const f32x4*)(pe + 8 * q), e1 = *(const f32x4*)(pe + 8 * q + 4);
                u32x4 o;
                o.x = pk2(bflo(x[q].x) + e0.x, bfhi(x[q].x) + e0.y); o.y = pk2(bflo(x[q].y) + e0.z, bfhi(x[q].y) + e0.w);
                o.z = pk2(bflo(x[q].z) + e1.x, bfhi(x[q].z) + e1.y); o.w = pk2(bflo(x[q].w) + e1.z, bfhi(x[q].w) + e1.w);
                dst[q] = o;
            }
        }
    }
    if (PART == 2) {
        const float* flogT = (const float*)(ws + WS_FLOGT); const float* bfg = (const float*)p.in[11];
        float* cfl = (float*)(ws + WS_CFL);
        const int gw = blockIdx.x * 8 + wave, NGW = gridDim.x * 8;
        for (int s = gw; s < 128; s += NGW) {
            const int b = s >> 3, hh = s & 7; const float bias = bfg[hh];
            const f32x4* src = (const f32x4*)(flogT + (size_t)hh * M + (size_t)b * T + 64 * lane);
            f32x4 v[16];
#pragma unroll
            for (int i = 0; i < 16; ++i) v[i] = src[i];
            float run = 0.f;
#pragma unroll
            for (int i = 0; i < 16; ++i)
#pragma unroll
                for (int j = 0; j < 4; ++j) { const float z = v[i][j] + bias; run += fminf(z, 0.f) - log1pf(expf(-fabsf(z))); v[i][j] = run; }
            float incl = run;
#pragma unroll
            for (int o = 1; o < 64; o <<= 1) { const float n = __shfl_up(incl, o); if (lane >= o) incl += n; }
            const float off = incl - run;
            f32x4* dst = (f32x4*)(cfl + (size_t)s * T + 64 * lane);
#pragma unroll
            for (int i = 0; i < 16; ++i) dst[i] = (v[i] + off) * LOG2E;
        }
    }
}

template <class PT> __device__ __forceinline__ void phase_cmp2(LAS char* lds, const PT& p, int tid) {
    unsigned char* ws = p.ws;
    const bf16_t* hid = (const bf16_t*)(ws + WS_HID);
    const float* w2k = (const float*)p.in[14]; const float* w2v = (const float*)p.in[17];
    const int lane = tid & 63, wave = tid >> 6;
    LAS float* w2s = (LAS float*)lds;
    for (int i = tid; i < 2 * 8192; i += 512) w2s[i] = (i < 8192) ? w2k[i] : w2v[i - 8192];
    __syncthreads();
    const int gw = blockIdx.x * 8 + wave, NGW = gridDim.x * 8;
    for (int row = gw; row < 16384; row += NGW) {
        const int kv = row >> 13, rr = row & 8191;
        const unsigned hv = *(const unsigned*)(hid + (size_t)row * 256 + kv * 128 + 2 * lane);
        const LAS float* wp = w2s + kv * 8192 + lane;
        float a0 = 0.f, a1 = 0.f;
#pragma unroll
        for (int j = 0; j < 64; ++j) {
            const unsigned hj = (unsigned)__builtin_amdgcn_readlane((int)hv, j);
            a0 += bflo(hj) * wp[(2 * j) * 64]; a1 += bfhi(hj) * wp[(2 * j + 1) * 64];
        }
        bf16_t* dst = (bf16_t*)(ws + (kv ? WS_VC : WS_KC)) + (size_t)rr * 64 + lane;
        *dst = (bf16_t)(pk2(a0 + a1, 0.f) & 0xffffu);
    }
    __syncthreads();
}

#define CAS __attribute__((address_space(4)))
#define RELOAD_P() do { pp = (const CAS Params*)__builtin_amdgcn_kernarg_segment_ptr(); asm volatile("" : "+s"(pp)); ws = pp->ws; x = (const float*)pp->in[0]; out = pp->out; mod = (float*)(ws + WS_MOD); H = (bf16_t*)(ws + WS_H); BIG = (bf16_t*)(ws + WS_BIG); tid = threadIdx.x; asm volatile("" : "+v"(tid)); } while (0)
__global__ void __launch_bounds__(512, 2) mega_fwd(Params p_in) {
    const CAS Params* pp;
    extern __shared__ __attribute__((aligned(16))) unsigned char lds_raw[];
    LAS unsigned char* lds = (LAS unsigned char*)lds_raw;
    cg::grid_group grid = cg::this_grid();
    { volatile LAS unsigned* stz = (volatile LAS unsigned*)(lds + 131072 + 64); if (threadIdx.x < 4) stz[threadIdx.x] = 0u; }
    __syncthreads();
    const XcdBarrier xbar = xcd_barrier_post((unsigned*)(p_in.ws + WS_CTL), (volatile LAS unsigned*)(lds + 131072 + 64));
    int tid = threadIdx.x;
    unsigned char* ws; const float* x; float* out; float* mod; bf16_t* H; bf16_t* BIG;
    const int G = gridDim.x, bx = blockIdx.x;
    RELOAD_P();

    phase_weights((LAS char*)lds, *pp, tid);
#ifdef PROBE_P0A2
    __syncthreads(); phase_weights((LAS char*)lds, *pp, tid);
#endif
    if (pp->ws == nullptr) grid.sync();
    xcd_barrier(xbar); RELOAD_P();
    phase_norm_mod(x, (const float*)pp->in[5], mod, 0, 1, H, tid);
    xcd_barrier(xbar); RELOAD_P();
#ifdef PROBE_SYNC10
    for (int i_ = 0; i_ < 10; ++i_) grid.sync();
#endif
#ifdef PROBE_NORM2
    phase_norm_mod(x, (const float*)pp->in[5], mod, 0, 1, H, tid); phase_norm_mod(x, (const float*)pp->in[5], mod, 0, 1, H, tid); phase_norm_mod(x, (const float*)pp->in[5], mod, 0, 1, H, tid);
#endif
    { pg8::Gemm g{H, (const bf16_t*)(ws + WS_WGU1), M, 5632, 1024}; pg8::StaticOrder S; S.init(M, 5632, G, bx);
      pg8::EpiSwiglu E{BIG}; pg8::gemm_phase<pg8::EpiSwiglu, pg8::StaticOrder, true, true>(lds, g, S, E);
#ifdef PROBE_P1X2
      pg8::gemm_phase<pg8::EpiSwiglu, pg8::StaticOrder, true, true>(lds, g, S, E);
#endif
    }
    xcd_barrier(xbar); RELOAD_P();
    { pg8::Gemm g{BIG, (const bf16_t*)(ws + WS_WD1), M, 1024, DFF}; pg8::StaticOrder S; S.init(M, 1024, G, bx);
      pg8::EpiResid E{x, out, mod + 2 * 1024, 0.5f}; pg8::gemm_phase<pg8::EpiResid, pg8::StaticOrder, true, true>(lds, g, S, E); }
    xcd_barrier(xbar); RELOAD_P();
    phase_norm_mod(out, (const float*)pp->in[9], mod, 3, 4, H, tid);
    xcd_barrier(xbar); RELOAD_P();
    { pg8::Gemm g{H, (const bf16_t*)(ws + WS_WIN), M, NIN_PAD, 1024}; pg8::StaticOrder S; S.init(M, NIN_PAD, G, bx);
      pg8::EpiProj E{BIG, (float*)(ws + WS_SMALL), (float*)(ws + WS_FLOGT)}; pg8::gemm_phase<pg8::EpiProj, pg8::StaticOrder, true, true>(lds, g, S, E); }
    xcd_barrier(xbar); RELOAD_P();
    phase_post<2>(*pp, tid, bx, G);
#ifdef PROBE_POST2
    grid.sync(); RELOAD_P(); phase_cmp2((LAS char*)lds, *pp, tid); phase_weights((LAS char*)lds, *pp, tid);
#endif
    xcd_barrier(xbar); RELOAD_P();
    if (bx < 64 || G <= 64) { pg8::Gemm g{(const bf16_t*)(ws + WS_ACMP), (const bf16_t*)(ws + WS_WC), 16384, 256, 2048}; pg8::StaticOrder S; S.init(16384, 256, G, bx);
      pg8::EpiGelu E{(bf16_t*)(ws + WS_HID)}; pg8::gemm_phase<pg8::EpiGelu, pg8::StaticOrder, true, true>(lds, g, S, E); }
    if (G <= 64) phase_post<1>(*pp, tid, bx, G); else if (bx >= 64) phase_post<1>(*pp, tid, bx - 64, G - 64);
    xcd_barrier(xbar); RELOAD_P();
    phase_cmp2((LAS char*)lds, *pp, tid);
    xcd_barrier(xbar); RELOAD_P();
    { att::AttnArgs A{BIG, (const float*)(ws + WS_SMALL), (const float*)(ws + WS_CFL), (const bf16_t*)(ws + WS_KC), (const bf16_t*)(ws + WS_VC), (bf16_t*)(ws + WS_ONSA), (bf16_t*)(ws + WS_OFOX)};
      att::attn_phase((LAS char*)lds, A, (unsigned*)(ws + WS_CTL + 32768), tid);
#ifdef PROBE_ATTN2_DISABLED
      __syncthreads(); att::attn_phase((LAS char*)lds, A, tid);
#endif
    }
    xcd_barrier(xbar); RELOAD_P();
    { pg8::Gemm g{(const bf16_t*)(ws + WS_ONSA), (const bf16_t*)(ws + WS_WUPN), M, 1024, 512}; pg8::StaticOrder S; S.init(M, 1024, G, bx);
      pg8::EpiGate<false> E{BIG, C_GMN, H}; pg8::gemm_phase<pg8::EpiGate<false>, pg8::StaticOrder, true, true>(lds, g, S, E); }
    RELOAD_P();
    { pg8::Gemm g{(const bf16_t*)(ws + WS_OFOX), (const bf16_t*)(ws + WS_WUPF), M, 1024, 512}; pg8::StaticOrder S; S.init(M, 1024, G, bx);
      pg8::EpiGate<true> E{BIG, C_GMF, H}; pg8::gemm_phase<pg8::EpiGate<true>, pg8::StaticOrder, true, true>(lds, g, S, E); }
    xcd_barrier(xbar); RELOAD_P();
    { pg8::Gemm g{H, (const bf16_t*)(ws + WS_WO), M, 1024, 1024}; pg8::StaticOrder S; S.init(M, 1024, G, bx);
      pg8::EpiResid E{out, out, mod + 5 * 1024, 1.0f}; pg8::gemm_phase<pg8::EpiResid, pg8::StaticOrder, true, true>(lds, g, S, E); }
    xcd_barrier(xbar); RELOAD_P();
    phase_norm_mod(out, (const float*)pp->in[21], mod, 6, 7, H, tid);
    xcd_barrier(xbar); RELOAD_P();
    { pg8::Gemm g{H, (const bf16_t*)(ws + WS_WGU2), M, 5632, 1024}; pg8::StaticOrder S; S.init(M, 5632, G, bx);
      pg8::EpiSwiglu E{BIG}; pg8::gemm_phase<pg8::EpiSwiglu, pg8::StaticOrder, true, true>(lds, g, S, E); }
    xcd_barrier(xbar); RELOAD_P();
    { pg8::Gemm g{BIG, (const bf16_t*)(ws + WS_WD2), M, 1024, DFF}; pg8::StaticOrder S; S.init(M, 1024, G, bx);
      pg8::EpiResid E{out, out, mod + 8 * 1024, 0.5f}; pg8::gemm_phase<pg8::EpiResid, pg8::StaticOrder, true, true>(lds, g, S, E); }
    xcd_barrier(xbar); RELOAD_P();
    phase_final_norm(out, (const float*)pp->in[25], tid);
}

extern "C" void kernel_launch(void* const* d_in, const int* in_sizes, int n_in, void* d_out, int out_size, void* d_ws, size_t ws_size, hipStream_t stream) {
    static int grid = 0;
    if (grid == 0) {
        if (n_in != 26 || out_size != M * D || ws_size < WS_END) { fprintf(stderr, "kernel_launch: unexpected sizes n_in %d out %d ws %zu (need %zu)\n", n_in, out_size, ws_size, (size_t)WS_END); grid = -1; return; }
        int dev = 0, cus = 0, per_cu = 0;
        hipGetDevice(&dev); hipDeviceGetAttribute(&cus, hipDeviceAttributeMultiprocessorCount, dev);
        if (hipFuncSetAttribute((const void*)mega_fwd, hipFuncAttributeMaxDynamicSharedMemorySize, LDS_BYTES) != hipSuccess) { fprintf(stderr, "kernel_launch: hipFuncSetAttribute failed\n"); grid = -1; return; }
        if (hipOccupancyMaxActiveBlocksPerMultiprocessor(&per_cu, (const void*)mega_fwd, 512, LDS_BYTES) != hipSuccess || per_cu < 1) { fprintf(stderr, "kernel_launch: occupancy query says %d\n", per_cu); per_cu = 1; }
        (void)hipGetLastError();
        grid = cus * 1;
    }
    if (grid < 0) return;
    if (hipMemsetAsync((char*)d_ws + WS_CTL, 0, CTL_BYTES, stream) != hipSuccess) { fprintf(stderr, "kernel_launch: memset failed\n"); return; }
    Params p{};
    for (int i = 0; i < 26; ++i) p.in[i] = d_in[i];
    p.out = (float*)d_out; p.ws = (unsigned char*)d_ws;
    void* args[] = {&p};
    hipError_t e = hipLaunchCooperativeKernel((const void*)mega_fwd, dim3(grid), dim3(512), args, LDS_BYTES, stream);
    if (e != hipSuccess) fprintf(stderr, "cooperative launch failed: %s (grid %d)\n", hipGetErrorString(e), grid);
}
```

```cpp
#include <hip/hip_runtime.h>
#include <hip/hip_cooperative_groups.h>
#include <cstdio>
#include <cstdint>
#include <cmath>
namespace cg = cooperative_groups;
namespace pg8 {
#define PG8_LAS __attribute__((address_space(3)))
typedef unsigned short bf16_t;
typedef short bf16x8 __attribute__((ext_vector_type(8)));
typedef float f32x4 __attribute__((ext_vector_type(4)));
typedef unsigned u32x4 __attribute__((ext_vector_type(4)));
constexpr int BM = 256, BK = 64, HALF = 128, HTB = HALF * BK * 2  , STAGE_BYTES = 8 * HTB, NXCD = 8, WGM = 8;

__host__ __device__ __forceinline__ int lds_byte(int r, int c) { const int st = (r >> 4) * 2 + (c >> 5), rr = r & 15, cc = c & 31, ob = rr * 64 + cc * 2; return st * 1024 + (ob ^ (((ob >> 9) & 1) << 5)); }
__host__ __device__ __forceinline__ void stage_rc(int b, int& R, int& C) { const int st = b / 1024, sb = b % 1024, swz = sb ^ (((sb >> 9) & 1) << 5); R = (st >> 1) * 16 + swz / 64; C = (st & 1) * 32 + (swz % 64) / 2; }
__host__ __device__ __forceinline__ int perm32(int rho) { const int n = rho >> 4, i = rho & 15; return 8 * (i >> 2) + 4 * n + (i & 3); }

struct Unit { int pm, pn; };
struct Gemm { const bf16_t* A; const bf16_t* Bt; int M, N, K; };

struct StaticOrder {
    int nM, nN, nwg, G, c;
    __host__ __device__ void init(int M, int N, int G_, int c_) { nM = M / BM; nN = N / BM; nwg = nM * nN; G = G_; c = c_; }
    __host__ __device__ bool next(int i, Unit& u) const {
        const long L = (long)i * G + c; if (L >= nwg) return false;
        int wgid = (int)L; { const int q = nwg / NXCD, r = nwg % NXCD, xcd = wgid % NXCD, off = wgid / NXCD; wgid = (xcd < r ? xcd * (q + 1) : r * (q + 1) + (xcd - r) * q) + off; }
        const int nig = WGM * nN, gid = wgid / nig, fm = gid * WGM, gsz = (nM - fm) < WGM ? (nM - fm) : WGM;
        u.pm = fm + ((wgid % nig) % gsz); u.pn = (wgid % nig) / gsz; return true;
    }
    __device__ __forceinline__ void a_ready(const Unit&) const {}
    __device__ __forceinline__ void done(const Unit&) const {}
};

__device__ __forceinline__ unsigned cvt_pk_bf16(float lo, float hi) { unsigned r; asm volatile("v_cvt_pk_bf16_f32 %0, %1, %2" : "=v"(r) : "v"(lo), "v"(hi)); return r; }
typedef float f32x2 __attribute__((ext_vector_type(2)));
__device__ __forceinline__ f32x2 gelu_pk(f32x2 v) {
    const f32x2 av = __builtin_elementwise_abs(v), d = av * 0.2316418882f + 1.0f;
    f32x2 t; t.x = __builtin_amdgcn_rcpf(d.x); t.y = __builtin_amdgcn_rcpf(d.y);
    f32x2 q = t * 0.5307027145f + (-0.7265760135f); q = q * t + 0.7107068705f; q = q * t + (-0.142248368f); q = q * t + 0.127414796f; q = q * t;
    const f32x2 s = (v * v) * (-0.72134752044f);
    f32x2 e; e.x = __builtin_amdgcn_exp2f(s.x); e.y = __builtin_amdgcn_exp2f(s.y);
    const f32x2 m = v * (q * e), r = v - m;
    f32x2 o; o.x = v.x < 0.f ? m.x : r.x; o.y = v.y < 0.f ? m.y : r.y; return o;
}

template <int ACT  > struct EpiBf16 {
    static constexpr bool PERM = true, AFTER_DRAIN = false; static_assert(ACT == 0 || ACT == 1, "EpiBf16: ACT is 0 (none) or 1 (gelu_pk)");
    bf16_t* O; int ldc; const float* bias; int split_cols; size_t split_stride; float scale0;
    __device__ __forceinline__ void operator()(const f32x4 (&acc)[2][2][4][2], const Unit& u, int wr, int wc, int fr, int fq) const {
        const int row0 = u.pm * BM + wr * 64 + fr; int colt = u.pn * BM; bf16_t* base = O;
        float sc = 1.f; if (split_cols) { const int t = colt / split_cols; base += (size_t)t * split_stride; colt -= t * split_cols; if (t == 0) sc = scale0; }
        const int col0 = colt + wc * 32 + 8 * fq, bcol0 = u.pn * BM + wc * 32 + 8 * fq;
        f32x4 bv[2][2];
#pragma unroll
        for (int bj = 0; bj < 2; ++bj)
#pragma unroll
            for (int n = 0; n < 2; ++n) bv[bj][n] = bias ? *(const f32x4*)(bias + bcol0 + bj * HALF + 4 * n) : (f32x4){0.f, 0.f, 0.f, 0.f};
#pragma unroll
        for (int ai = 0; ai < 2; ++ai)
#pragma unroll
            for (int m = 0; m < 4; ++m) { bf16_t* rowp = base + (size_t)(row0 + ai * HALF + m * 16) * ldc + col0;
#pragma unroll
                for (int bj = 0; bj < 2; ++bj) { f32x4 v0 = acc[ai][bj][m][0] + bv[bj][0], v1 = acc[ai][bj][m][1] + bv[bj][1];
                    if (ACT == 1) { f32x2 a = gelu_pk((f32x2){v0[0], v0[1]}), b = gelu_pk((f32x2){v0[2], v0[3]}), c = gelu_pk((f32x2){v1[0], v1[1]}), d = gelu_pk((f32x2){v1[2], v1[3]});
                        v0 = (f32x4){a.x, a.y, b.x, b.y}; v1 = (f32x4){c.x, c.y, d.x, d.y}; }
                    v0 = v0 * sc; v1 = v1 * sc; u32x4 w; w.x = cvt_pk_bf16(v0[0], v0[1]); w.y = cvt_pk_bf16(v0[2], v0[3]); w.z = cvt_pk_bf16(v1[0], v1[1]); w.w = cvt_pk_bf16(v1[2], v1[3]);
                    *(u32x4*)(rowp + bj * HALF) = w; } }
    }
};
template <class Epi, class Sched, bool ALIGN_EPI = false, bool SP2 = false>
__device__ __forceinline__ void gemm_phase(PG8_LAS unsigned char* lds, const Gemm g, const Sched& S, const Epi& E) {
    int tid_ = threadIdx.x; asm volatile("" : "+v"(tid_));
    const int tid = tid_, wid = __builtin_amdgcn_readfirstlane(tid >> 6), lane = tid & 63, wr = wid >> 2, wc = wid & 3, fr = lane & 15, fq = lane >> 4;
    const int K = g.K, nt = K / BK;
    unsigned voffA[2], voffB[2];
#pragma unroll
    for (int i = 0; i < 2; ++i) { int R, C; stage_rc(tid * 16 + i * 8192, R, C); const int Rb = Epi::PERM ? ((R & ~31) + perm32(R & 31)) : R;
        voffA[i] = (unsigned)(R * K + C) * 2u; voffB[i] = (unsigned)(Rb * K + C) * 2u; }
    const size_t kstep = (size_t)(BK * 2);
    const size_t hstep = (size_t)HALF * K * 2;
    const size_t tstep = 2 * hstep;
    const unsigned ldsw = (unsigned)wid * 1024u;
    const int aoff = lds_byte(wr * 64 + fr, fq * 8), boff = lds_byte(wc * 32 + fr, fq * 8);
#define PG8_SA(b, h) (((b) * 2 + (h)) * HTB)
#define PG8_SB(b, h) ((4 + (b) * 2 + (h)) * HTB)
#define PG8_STAGE(bufoff, gbase, voff) do { _Pragma("unroll") for (int _i = 0; _i < 2; ++_i) \
        __builtin_amdgcn_global_load_lds((const unsigned*)((const char*)(gbase) + (voff)[_i]), (PG8_LAS unsigned*)(lds + (bufoff) + ldsw + _i * 8192), 16, 0, 0); } while (0)
#define PG8_LDA(dst, b, h) do { _Pragma("unroll") for (int m = 0; m < 4; ++m) _Pragma("unroll") for (int k = 0; k < 2; ++k) dst[m][k] = *(const PG8_LAS bf16x8*)(lds + PG8_SA(b, h) + aoff + m * 2048 + k * 1024); } while (0)
#define PG8_LDB(dst, b, h) do { _Pragma("unroll") for (int n = 0; n < 2; ++n) _Pragma("unroll") for (int k = 0; k < 2; ++k) dst[n][k] = *(const PG8_LAS bf16x8*)(lds + PG8_SB(b, h) + boff + n * 2048 + k * 1024); } while (0)
#define PG8_MMA(ai, bj, At, Bt) do { __builtin_amdgcn_s_setprio(1); _Pragma("unroll") for (int m = 0; m < 4; ++m) _Pragma("unroll") for (int n = 0; n < 2; ++n) _Pragma("unroll") for (int k = 0; k < 2; ++k) \
        acc[ai][bj][m][n] = __builtin_amdgcn_mfma_f32_16x16x32_bf16(Bt[n][k], At[m][k], acc[ai][bj][m][n], 0, 0, 0); __builtin_amdgcn_s_setprio(0); } while (0)
#define PG8_WAIT_V(n) asm volatile("s_waitcnt vmcnt(" #n ")" ::: "memory")
#define PG8_WAIT_L(n) asm volatile("s_waitcnt lgkmcnt(" #n ")" ::: "memory")
#define PG8_BAR __builtin_amdgcn_s_barrier()
#define PG8_SCHED __builtin_amdgcn_sched_barrier(0)
    Unit cur, nxt; int ui = 0;
    if (!S.next(0, cur)) return;
    f32x4 acc[2][2][4][2];
#pragma unroll
    for (int a = 0; a < 2; ++a)
#pragma unroll
        for (int b = 0; b < 2; ++b)
#pragma unroll
            for (int m = 0; m < 4; ++m)
#pragma unroll
                for (int n = 0; n < 2; ++n) acc[a][b][m][n] = (f32x4){0.f, 0.f, 0.f, 0.f};
    bf16x8 At[4][2], B0[2][2], B1[2][2];
    const char* cA = (const char*)g.A + (size_t)cur.pm * tstep; const char* cB = (const char*)g.Bt + (size_t)cur.pn * tstep;
    S.a_ready(cur);
    if constexpr (SP2) {
        PG8_STAGE(PG8_SB(0, 0), cB, voffB); PG8_STAGE(PG8_SB(0, 1), cB + hstep, voffB); PG8_STAGE(PG8_SA(0, 0), cA, voffA); PG8_STAGE(PG8_SA(0, 1), cA + hstep, voffA);
        if (wr == 1) PG8_BAR;
        PG8_WAIT_V(2); PG8_BAR;
        PG8_STAGE(PG8_SB(1, 0), cB + kstep, voffB); PG8_STAGE(PG8_SA(1, 0), cA + kstep, voffA); PG8_STAGE(PG8_SB(1, 1), cB + hstep + kstep, voffB);
        PG8_WAIT_V(6); PG8_BAR;
    } else {
        PG8_STAGE(PG8_SB(0, 0), cB, voffB); PG8_STAGE(PG8_SA(0, 0), cA, voffA); PG8_STAGE(PG8_SB(0, 1), cB + hstep, voffB); PG8_STAGE(PG8_SA(0, 1), cA + hstep, voffA);
        if (wr == 1) PG8_BAR;
        PG8_WAIT_V(4); PG8_BAR;
        PG8_STAGE(PG8_SB(1, 0), cB + kstep, voffB); PG8_STAGE(PG8_SA(1, 0), cA + kstep, voffA); PG8_STAGE(PG8_SB(1, 1), cB + hstep + kstep, voffB);
        PG8_WAIT_V(6); PG8_BAR;
    }
    for (;;) {
        const bool has_next = S.next(ui + 1, nxt);
        const char* nA = has_next ? (const char*)g.A + (size_t)nxt.pm * tstep : cA; const char* nB = has_next ? (const char*)g.Bt + (size_t)nxt.pn * tstep : cB;
        for (int t = 0; t < nt; t += 2) {
            const bool last = (t == nt - 2);
            const char* a1 = cA + (size_t)(t + 1) * kstep;
            const char* a2 = last ? nA : cA + (size_t)(t + 2) * kstep; const char* b2 = last ? nB : cB + (size_t)(t + 2) * kstep;
            const char* a3 = a2 + kstep; const char* b3 = b2 + kstep;
            if (last && has_next) S.a_ready(nxt);
            if constexpr (SP2) {
            PG8_LDB(B0, 0, 0); PG8_LDB(B1, 0, 1); PG8_SCHED; PG8_LDA(At, 0, 0); PG8_STAGE(PG8_SA(1, 1), a1 + hstep, voffA);
            PG8_WAIT_V(8); PG8_WAIT_L(0); PG8_BAR; PG8_MMA(0, 0, At, B0); PG8_MMA(0, 1, At, B1); PG8_BAR; PG8_SCHED;
            PG8_LDA(At, 0, 1); PG8_STAGE(PG8_SB(0, 0), b2, voffB); PG8_STAGE(PG8_SB(0, 1), b2 + hstep, voffB); PG8_STAGE(PG8_SA(0, 0), a2, voffA);
            PG8_WAIT_V(8); PG8_WAIT_L(0); PG8_BAR; PG8_MMA(1, 0, At, B0); PG8_MMA(1, 1, At, B1); PG8_BAR; PG8_SCHED;
            PG8_LDB(B0, 1, 0); PG8_LDB(B1, 1, 1); PG8_SCHED; PG8_LDA(At, 1, 0); PG8_STAGE(PG8_SA(0, 1), a2 + hstep, voffA);
            PG8_WAIT_V(8); PG8_WAIT_L(0); PG8_BAR; PG8_MMA(0, 0, At, B0); PG8_MMA(0, 1, At, B1); PG8_BAR; PG8_SCHED;
            PG8_LDA(At, 1, 1); PG8_STAGE(PG8_SB(1, 0), b3, voffB); PG8_STAGE(PG8_SB(1, 1), b3 + hstep, voffB); PG8_STAGE(PG8_SA(1, 0), a3, voffA);
            PG8_WAIT_V(8); PG8_WAIT_L(0); PG8_BAR; PG8_MMA(1, 0, At, B0); PG8_MMA(1, 1, At, B1); PG8_BAR; PG8_SCHED;
            } else {
            PG8_LDB(B0, 0, 0); PG8_SCHED; PG8_LDA(At, 0, 0); PG8_STAGE(PG8_SA(1, 1), a1 + hstep, voffA);
            PG8_WAIT_L(8); PG8_BAR; PG8_WAIT_L(0); PG8_MMA(0, 0, At, B0); PG8_BAR; PG8_SCHED;
            PG8_LDB(B1, 0, 1); PG8_STAGE(PG8_SB(0, 0), b2, voffB);
            PG8_BAR; PG8_WAIT_L(0); PG8_MMA(0, 1, At, B1); PG8_BAR;
            PG8_LDA(At, 0, 1); PG8_STAGE(PG8_SA(0, 0), a2, voffA);
            PG8_BAR; PG8_WAIT_L(0); PG8_MMA(1, 0, At, B0); PG8_BAR; PG8_SCHED;
            PG8_STAGE(PG8_SB(0, 1), b2 + hstep, voffB);
            PG8_WAIT_V(6); PG8_BAR; PG8_MMA(1, 1, At, B1); PG8_BAR;
            PG8_LDB(B0, 1, 0); PG8_SCHED; PG8_LDA(At, 1, 0); PG8_STAGE(PG8_SA(0, 1), a2 + hstep, voffA);
            PG8_WAIT_L(8); PG8_BAR; PG8_WAIT_L(0); PG8_MMA(0, 0, At, B0); PG8_BAR; PG8_SCHED;
            PG8_LDB(B1, 1, 1); PG8_STAGE(PG8_SB(1, 0), b3, voffB);
            PG8_BAR; PG8_WAIT_L(0); PG8_MMA(0, 1, At, B1); PG8_BAR;
            PG8_LDA(At, 1, 1); PG8_STAGE(PG8_SA(1, 0), a3, voffA);
            PG8_BAR; PG8_WAIT_L(0); PG8_MMA(1, 0, At, B0); PG8_BAR; PG8_SCHED;
            PG8_STAGE(PG8_SB(1, 1), b3 + hstep, voffB);
            PG8_WAIT_V(6); PG8_BAR; PG8_MMA(1, 1, At, B1); PG8_BAR;
            }
        }
        if constexpr (ALIGN_EPI) { if (wr == 0) PG8_BAR; }
        if constexpr (!Epi::AFTER_DRAIN) { E(acc, cur, wr, wc, fr, fq); S.done(cur); }
        if (!has_next) break;
#pragma unroll
        for (int a = 0; a < 2; ++a)
#pragma unroll
            for (int b = 0; b < 2; ++b)
#pragma unroll
                for (int m = 0; m < 4; ++m)
#pragma unroll
                    for (int n = 0; n < 2; ++n) acc[a][b][m][n] = (f32x4){0.f, 0.f, 0.f, 0.f};
        cur = nxt; cA = nA; cB = nB; ++ui;
        if constexpr (ALIGN_EPI) { if (wr == 1) PG8_BAR; }
    }
    PG8_WAIT_V(0);
    if constexpr (!ALIGN_EPI) { if (wr == 0) PG8_BAR; }
    PG8_BAR;
    if constexpr (Epi::AFTER_DRAIN) { E.fused(acc, cur, wr, wc, fr, fq, lds, wid, lane); S.done(cur); }
#undef PG8_SA
#undef PG8_SB
#undef PG8_STAGE
#undef PG8_LDA
#undef PG8_LDB
#undef PG8_MMA
#undef PG8_WAIT_V
#undef PG8_WAIT_L
#undef PG8_BAR
#undef PG8_SCHED
}
}
constexpr int D = 1024, NB = 16, T = 4096, M = NB * T, DFF = 2816;
constexpr int PITCH = 4864;
constexpr int NIN_PAD = 5120;
constexpr int C_QN = 0, C_KC = 512, C_VC = 640, C_KS = 768, C_VS = 896, C_KW = 1024, C_VW = 1152, C_QF = 1280, C_KF = 1792, C_VF = 2304, C_GMN = 2816, C_GMF = 3840;
constexpr float LOG2E = 1.4426950408889634f;
constexpr float C2 = 0.125f * LOG2E;
#define LAS __attribute__((address_space(3)))
typedef float f32x16 __attribute__((ext_vector_type(16)));
typedef short s16x4 __attribute__((ext_vector_type(4)));
typedef float f32x2v __attribute__((ext_vector_type(2)));
typedef __bf16 bf16x2v __attribute__((ext_vector_type(2)));
__device__ __forceinline__ unsigned pk2(float lo, float hi) { f32x2v v = {lo, hi}; bf16x2v b = __builtin_convertvector(v, bf16x2v); return __builtin_bit_cast(unsigned, b); }
__device__ __forceinline__ float bflo(unsigned u) { return __uint_as_float(u << 16); }
__device__ __forceinline__ float bfhi(unsigned u) { return __uint_as_float(u & 0xffff0000u); }
__device__ __forceinline__ float bf2f(unsigned short u) { return __uint_as_float(((unsigned)u) << 16); }
__device__ __forceinline__ float sigmoidf_(float x) { return __builtin_amdgcn_rcpf(1.f + __builtin_amdgcn_exp2f(-x * LOG2E)); }

namespace pg8 {
struct EpiSwiglu {
    static constexpr bool PERM = true, AFTER_DRAIN = false;
    bf16_t* O;
    __device__ __forceinline__ void operator()(const f32x4 (&acc)[2][2][4][2], const Unit& u, int wr, int wc, int fr, int fq) const {
        const int row0 = u.pm * BM + wr * 64 + fr; const int col0 = u.pn * 128 + wc * 32 + 8 * fq;
#pragma unroll
        for (int ai = 0; ai < 2; ++ai)
#pragma unroll
            for (int m = 0; m < 4; ++m) {
                bf16_t* p = O + (size_t)(row0 + ai * HALF + m * 16) * DFF + col0;
                float a[8];
#pragma unroll
                for (int n = 0; n < 2; ++n)
#pragma unroll
                    for (int j = 0; j < 4; ++j) { const float g = acc[ai][0][m][n][j], up = acc[ai][1][m][n][j]; a[n * 4 + j] = g * sigmoidf_(g) * up; }
                u32x4 w; w.x = pk2(a[0], a[1]); w.y = pk2(a[2], a[3]); w.z = pk2(a[4], a[5]); w.w = pk2(a[6], a[7]);
                *(u32x4*)p = w;
            }
    }
};
struct EpiResid {
    static constexpr bool PERM = false, AFTER_DRAIN = false;
    const float* base; float* out; const float* gate; float s;
    __device__ __forceinline__ void operator()(const f32x4 (&acc)[2][2][4][2], const Unit& u, int wr, int wc, int fr, int fq) const {
        const int row0 = u.pm * BM + wr * 64 + fr; const int col0 = u.pn * BM + wc * 32 + 4 * fq;
        const int b = (u.pm * BM) >> 12;
#pragma unroll
        for (int bj = 0; bj < 2; ++bj)
#pragma unroll
            for (int n = 0; n < 2; ++n) {
                const int c = col0 + bj * HALF + n * 16;
                const f32x4 g4 = *(const f32x4*)(gate + (size_t)b * 9216 + c) * s;
#pragma unroll
                for (int ai = 0; ai < 2; ++ai)
#pragma unroll
                    for (int m = 0; m < 4; ++m) {
                        const size_t off = (size_t)(row0 + ai * HALF + m * 16) * D + c;
                        const f32x4 bs = *(const f32x4*)(base + off);
                        *(f32x4*)(out + off) = bs + g4 * acc[ai][bj][m][n];
                    }
            }
    }
};
struct EpiProj {
    static constexpr bool PERM = true, AFTER_DRAIN = false;
    bf16_t* P; float* small; float* flogT;
    __device__ __forceinline__ void operator()(const f32x4 (&acc)[2][2][4][2], const Unit& u, int wr, int wc, int fr, int fq) const {
        const int row0 = u.pm * BM + wr * 64 + fr;
        if (u.pn < 19) {
            const float sc = (u.pn < 2 || u.pn == 5 || u.pn == 6) ? C2 : 1.f;
            const int col0 = u.pn * BM + wc * 32 + 8 * fq;
#pragma unroll
            for (int ai = 0; ai < 2; ++ai)
#pragma unroll
                for (int m = 0; m < 4; ++m) {
                    bf16_t* rowp = P + (size_t)(row0 + ai * HALF + m * 16) * PITCH + col0;
#pragma unroll
                    for (int bj = 0; bj < 2; ++bj) {
                        const f32x4 v0 = acc[ai][bj][m][0] * sc, v1 = acc[ai][bj][m][1] * sc;
                        u32x4 w; w.x = pk2(v0[0], v0[1]); w.y = pk2(v0[2], v0[3]); w.z = pk2(v1[0], v1[1]); w.w = pk2(v1[2], v1[3]);
                        *(u32x4*)(rowp + bj * HALF) = w;
                    }
                }
        } else if (wc == 0) {
#pragma unroll
            for (int ai = 0; ai < 2; ++ai)
#pragma unroll
                for (int m = 0; m < 4; ++m) {
                    const int row = row0 + ai * HALF + m * 16;
                    float* sp = small + (size_t)row * 32 + 8 * fq;
                    *(f32x4*)sp = acc[ai][0][m][0]; *(f32x4*)(sp + 4) = acc[ai][0][m][1];
                    if (fq == 3) {
#pragma unroll
                        for (int j = 0; j < 4; ++j) { flogT[(size_t)j * M + row] = acc[ai][0][m][0][j]; flogT[(size_t)(4 + j) * M + row] = acc[ai][0][m][1][j]; } }
                }
        }
    }
};
template <bool ADD> struct EpiGate {
    static constexpr bool PERM = true, AFTER_DRAIN = false;
    const bf16_t* proj; int gcol; bf16_t* O;
    __device__ __forceinline__ void operator()(const f32x4 (&acc)[2][2][4][2], const Unit& u, int wr, int wc, int fr, int fq) const {
        const int row0 = u.pm * BM + wr * 64 + fr; const int col0 = u.pn * BM + wc * 32 + 8 * fq;
#pragma unroll
        for (int ai = 0; ai < 2; ++ai)
#pragma unroll
            for (int m = 0; m < 4; ++m) {
                const size_t row = (size_t)(row0 + ai * HALF + m * 16);
#pragma unroll
                for (int bj = 0; bj < 2; ++bj) {
                    const int c = col0 + bj * HALF;
                    const u32x4 gm = *(const u32x4*)(proj + row * PITCH + gcol + c);
                    bf16_t* op = O + row * D + c;
                    float v[8];
                    v[0] = sigmoidf_(bflo(gm.x)) * acc[ai][bj][m][0][0]; v[1] = sigmoidf_(bfhi(gm.x)) * acc[ai][bj][m][0][1];
                    v[2] = sigmoidf_(bflo(gm.y)) * acc[ai][bj][m][0][2]; v[3] = sigmoidf_(bfhi(gm.y)) * acc[ai][bj][m][0][3];
                    v[4] = sigmoidf_(bflo(gm.z)) * acc[ai][bj][m][1][0]; v[5] = sigmoidf_(bfhi(gm.z)) * acc[ai][bj][m][1][1];
                    v[6] = sigmoidf_(bflo(gm.w)) * acc[ai][bj][m][1][2]; v[7] = sigmoidf_(bfhi(gm.w)) * acc[ai][bj][m][1][3];
                    if (ADD) { const u32x4 pv = *(const u32x4*)op;
                        v[0] += bflo(pv.x); v[1] += bfhi(pv.x); v[2] += bflo(pv.y); v[3] += bfhi(pv.y); v[4] += bflo(pv.z); v[5] += bfhi(pv.z); v[6] += bflo(pv.w); v[7] += bfhi(pv.w); }
                    u32x4 w; w.x = pk2(v[0], v[1]); w.y = pk2(v[2], v[3]); w.z = pk2(v[4], v[5]); w.w = pk2(v[6], v[7]);
                    *(u32x4*)op = w;
                }
            }
    }
};
struct EpiGelu {
    static constexpr bool PERM = true, AFTER_DRAIN = false;
    bf16_t* O;
    __device__ __forceinline__ static float gelu(float x) { const float uu = 0.7978845608028654f * (x + 0.044715f * x * x * x); return x * sigmoidf_(2.f * uu); }
    __device__ __forceinline__ void operator()(const f32x4 (&acc)[2][2][4][2], const Unit& u, int wr, int wc, int fr, int fq) const {
        const int row0 = u.pm * BM + wr * 64 + fr; const int col0 = u.pn * BM + wc * 32 + 8 * fq;
#pragma unroll
        for (int ai = 0; ai < 2; ++ai)
#pragma unroll
            for (int m = 0; m < 4; ++m) {
                bf16_t* rowp = O + (size_t)(row0 + ai * HALF + m * 16) * 256 + col0;
#pragma unroll
                for (int bj = 0; bj < 2; ++bj) {
                    const f32x4 v0 = acc[ai][bj][m][0], v1 = acc[ai][bj][m][1];
                    u32x4 w; w.x = pk2(gelu(v0[0]), gelu(v0[1])); w.y = pk2(gelu(v0[2]), gelu(v0[3])); w.z = pk2(gelu(v1[0]), gelu(v1[1])); w.w = pk2(gelu(v1[2]), gelu(v1[3]));
                    *(u32x4*)(rowp + bj * HALF) = w;
                }
            }
    }
};
}
using pg8::bf16_t; using pg8::bf16x8; using pg8::f32x4; using pg8::u32x4;
#define XB_TMO      128
#define XB_XCNT(j)  (256  + 64 * (j))
#define XB_XSUB(j)  (1280 + 64 * (j))
#define XB_XGEN(j)  (2304 + 64 * (j))
#define XB_TOP      3328
#define XB_TOPGEN   3392
#define XCD_BAR_WORDS 3456
#define XB_SPIN_CAP (1u << 18)

__device__ __forceinline__ unsigned xb_ld(unsigned* p)              { return __hip_atomic_load(p, __ATOMIC_RELAXED, __HIP_MEMORY_SCOPE_AGENT); }
__device__ __forceinline__ unsigned xb_add(unsigned* p, unsigned v) { return __hip_atomic_fetch_add(p, v, __ATOMIC_RELAXED, __HIP_MEMORY_SCOPE_AGENT); }
__device__ __forceinline__ unsigned xb_xcc_id() { return (unsigned)__builtin_amdgcn_s_getreg((3 << 11) | 20) & 0xFu; }
#define XB_SPIN(cond, bar) do { unsigned _sp = 0; while (cond) { __builtin_amdgcn_s_sleep(1); \
    if ((++_sp & 255u) == 0u) { if (xb_ld(&(bar)[XB_TMO])) break; if (_sp > XB_SPIN_CAP) { atomicAdd(&(bar)[XB_TMO], 1u); break; } } } } while (0)

struct XcdBarrier {
    unsigned* bar; unsigned x;
    volatile LAS unsigned* st;
};

__device__ __forceinline__ XcdBarrier xcd_barrier_post(unsigned* bar, volatile LAS unsigned* st) {
    XcdBarrier b; b.bar = bar; b.x = xb_xcc_id(); b.st = st;
    if (threadIdx.x == 0) (void)xb_add(&bar[XB_XCNT(b.x)], 1u);
    return b;
}
__device__ __forceinline__ void xcd_barrier_complete(unsigned* bar, unsigned x, unsigned& nloc, unsigned& nx) {
    const unsigned G = gridDim.x * gridDim.y * gridDim.z;
    unsigned sum, cnt, mine, sp = 0u;
    for (;;) {
        sum = 0u; cnt = 0u; mine = 0u;
#pragma unroll
        for (unsigned j = 0; j < 16; ++j) { const unsigned c = xb_ld(&bar[XB_XCNT(j)]); sum += c; cnt += (c > 0u) ? 1u : 0u; mine = (j == x) ? c : mine; }
        if (sum == G) break;
        __builtin_amdgcn_s_sleep(1);
        if ((++sp & 255u) == 0u) { if (xb_ld(&bar[XB_TMO])) break; if (sp > XB_SPIN_CAP) { atomicAdd(&bar[XB_TMO], 1u); break; } }
    }
    nloc = mine > 0u ? mine : 1u; nx = cnt > 0u ? cnt : 1u;
}

__device__ __forceinline__ void xcd_barrier(const XcdBarrier& b) {
    asm volatile("s_waitcnt vmcnt(0)" ::: "memory");
    __syncthreads();
    if (threadIdx.x == 0) {
        unsigned* bar = b.bar;
        __builtin_amdgcn_s_waitcnt(0);
        unsigned nloc = b.st[0], nx = b.st[1];
        if (nloc == 0u) { xcd_barrier_complete(bar, b.x, nloc, nx); b.st[0] = nloc; b.st[1] = nx; }
        const unsigned old = xb_add(&bar[XB_XSUB(b.x)], 1u);
        const unsigned gen = old / nloc;
        if (old + 1u == (gen + 1u) * nloc) {
            __builtin_amdgcn_fence(__ATOMIC_RELEASE, "agent");
            asm volatile("s_waitcnt vmcnt(0)" ::: "memory");
            const unsigned og = xb_add(&bar[XB_TOP], 1u);
            const unsigned tg = og / nx;
            if (og + 1u == (tg + 1u) * nx) xb_add(&bar[XB_TOPGEN], 1u);
            else XB_SPIN(xb_ld(&bar[XB_TOPGEN]) == tg, bar);
            __builtin_amdgcn_fence(__ATOMIC_ACQUIRE, "agent");
            xb_add(&bar[XB_XGEN(b.x)], 1u);
            asm volatile("s_waitcnt vmcnt(0)" ::: "memory");
        } else {
            XB_SPIN(xb_ld(&bar[XB_XGEN(b.x)]) == gen, bar);
            __builtin_amdgcn_fence(__ATOMIC_ACQUIRE, "agent");
            asm volatile("s_waitcnt vmcnt(0)" ::: "memory");
        }
    }
    __syncthreads();
}
namespace att {
constexpr int KROW = 144;
constexpr int VROW = 192;
constexpr int KTILEB = 64 * KROW, VTILEB = 64 * VROW;
constexpr int L_K = 0, L_V = 2 * KTILEB, L_SEL = L_V + 2 * VTILEB, L_UNI = L_SEL + 512, L_IMP = 45056;
static_assert(L_UNI + 16 <= L_IMP, "attention LDS map");
typedef short v4i16_t __attribute__((ext_vector_type(4)));
__device__ __forceinline__ int crow(int i, int h) { return (i & 3) + 8 * (i >> 2) + 4 * h; }
__device__ __forceinline__ s16x4 vtr(const LAS char* p) { return __builtin_bit_cast(s16x4, __builtin_amdgcn_ds_read_tr16_b64_v4i16((LAS v4i16_t*)p)); }
#define MFMA32(a, b, c) __builtin_amdgcn_mfma_f32_32x32x16_bf16((a), (b), (c), 0, 0, 0)
__device__ __forceinline__ float max3f(float a, float b, float c) { float r; asm("v_max3_f32 %0, %1, %2, %3" : "=v"(r) : "v"(a), "v"(b), "v"(c)); return r; }
__device__ __forceinline__ float fadd_s(float a, float b) { float r; asm("v_add_f32_e32 %0, %1, %2" : "=v"(r) : "v"(a), "v"(b)); return r; }

template <bool BIAS>
__device__ __forceinline__ void tile_scores(const LAS char* Kb, const bf16x8 (&qf)[4], const bf16x8& qaug, const f32x16& negm, f32x16& p0, f32x16& p1,
                                            int key0, int lo, int hi, bool on, int lane) {
    const int r32 = lane & 31, h = lane >> 5;
    const LAS char* kp = Kb + r32 * KROW + h * 16;
    { const bf16x8 k0 = *(const LAS bf16x8*)(kp), k1 = *(const LAS bf16x8*)(kp + 32 * KROW);
      p0 = MFMA32(k0, qf[0], negm); p1 = MFMA32(k1, qf[0], negm); }
#pragma unroll
    for (int d0 = 1; d0 < 4; ++d0) {
        const bf16x8 k0 = *(const LAS bf16x8*)(kp + d0 * 32);
        const bf16x8 k1 = *(const LAS bf16x8*)(kp + 32 * KROW + d0 * 32);
        p0 = MFMA32(k0, qf[d0], p0); p1 = MFMA32(k1, qf[d0], p1);
    }
    if (BIAS) {
        const LAS char* ka = Kb + r32 * KROW + 128;
        const bf16x8 k0 = *(const LAS bf16x8*)(ka), k1 = *(const LAS bf16x8*)(ka + 32 * KROW);
        p0 = MFMA32(k0, qaug, p0); p1 = MFMA32(k1, qaug, p1);
    }
    const bool full = on && (key0 >= lo) && (key0 + 63 <= hi);
    if (!__all(full)) {
#pragma unroll
        for (int i = 0; i < 16; ++i) {
            const int k = key0 + crow(i, h);
            if (!(on && k >= lo && k <= hi)) p0[i] = -INFINITY;
            if (!(on && k + 32 >= lo && k + 32 <= hi)) p1[i] = -INFINITY;
        }
    }
}

__device__ __forceinline__ void apply_mask(f32x16& p0, f32x16& p1, int key0, int lo, int hi, bool on, int lane) {
    const int h = lane >> 5;
    const bool inrange = (key0 >= lo) && (key0 + 63 <= hi);
    if (__all(inrange)) {
        if (!__all(on)) {
#pragma unroll
            for (int i = 0; i < 16; ++i) { p0[i] = on ? p0[i] : -INFINITY; p1[i] = on ? p1[i] : -INFINITY; }
        }
    } else {
#pragma unroll
        for (int i = 0; i < 16; ++i) {
            const int k = key0 + crow(i, h);
            if (!(on && k >= lo && k <= hi)) p0[i] = -INFINITY;
            if (!(on && k + 32 >= lo && k + 32 <= hi)) p1[i] = -INFINITY;
        }
    }
}
struct Soft { float mhat, l; bool started; };

template <bool BIAS>
__device__ __forceinline__ void tile_compute(const LAS char* Kb, const LAS char* Vb, const bf16x8 (&qf)[4], const bf16x8& qaug,
                                             f32x16& o0, f32x16& o1, f32x16& negm, Soft& st, int key0, int lo, int hi, bool on, int lane) {
    const int r32 = lane & 31, h = lane >> 5;
    constexpr int NK = BIAS ? 5 : 4;
    bf16x8 ka[NK], kb[NK];
    { const LAS char* kp = Kb + r32 * KROW + h * 16;
#pragma unroll
      for (int d0 = 0; d0 < 4; ++d0) { ka[d0] = *(const LAS bf16x8*)(kp + d0 * 32); kb[d0] = *(const LAS bf16x8*)(kp + 32 * KROW + d0 * 32); }
      if (BIAS) { const LAS char* kq = Kb + r32 * KROW + 128; ka[NK - 1] = *(const LAS bf16x8*)(kq); kb[NK - 1] = *(const LAS bf16x8*)(kq + 32 * KROW); } }
    __builtin_amdgcn_sched_barrier(0);
    f32x16 p0, p1;

    p0 = MFMA32(ka[0], qf[0], negm); p1 = MFMA32(kb[0], qf[0], negm);
#pragma unroll
    for (int d0 = 1; d0 < 4; ++d0) { p0 = MFMA32(ka[d0], qf[d0], p0); p1 = MFMA32(kb[d0], qf[d0], p1); }
#ifdef PROBE_MFMA2
    { bf16x8 zq; for (int e = 0; e < 8; ++e) zq[e] = 0; asm volatile("" : "+v"(zq));
#pragma unroll
      for (int d0 = 0; d0 < 4; ++d0) { p0 = MFMA32(ka[d0], zq, p0); p1 = MFMA32(kb[d0], zq, p1); } }
#endif
    if (BIAS) { p0 = MFMA32(ka[NK - 1], qaug, p0); p1 = MFMA32(kb[NK - 1], qaug, p1); }

    bf16x8 v0[4], v1[4];
    { const int i16 = lane & 15, q = i16 >> 2, pp = i16 & 3, blk = (lane >> 4) & 1;
      const LAS char* vp = Vb + (4 * h + q) * VROW + (16 * blk + 4 * pp) * 2;
#pragma unroll
      for (int ks = 0; ks < 4; ++ks) {
          const LAS char* a = vp + (16 * ks) * VROW;
          const s16x4 l0 = vtr(a), h0 = vtr(a + 8 * VROW), l1 = vtr(a + 64), h1 = vtr(a + 8 * VROW + 64);
          v0[ks] = __builtin_shufflevector(l0, h0, 0, 1, 2, 3, 4, 5, 6, 7); v1[ks] = __builtin_shufflevector(l1, h1, 0, 1, 2, 3, 4, 5, 6, 7);
      } }
    __builtin_amdgcn_sched_barrier(0);
    apply_mask(p0, p1, key0, lo, hi, on, lane);
    asm volatile("s_nop 15\n\ts_nop 7" : "+v"(p0), "+v"(p1));
    float mx;
    { float a = max3f(p0[0], p0[1], p1[0]), b = max3f(p0[2], p0[3], p1[1]); a = max3f(a, p1[2], p1[3]);
#pragma unroll
      for (int r = 4; r < 16; r += 4) { a = max3f(a, p0[r], p0[r + 1]); b = max3f(b, p0[r + 2], p0[r + 3]); a = max3f(a, p1[r], p1[r + 1]); b = max3f(b, p1[r + 2], p1[r + 3]); }
      mx = fmaxf(a, b); }
    { auto rr_ = __builtin_amdgcn_permlane32_swap(__float_as_uint(mx), __float_as_uint(mx), false, false); mx = fmaxf(__uint_as_float(rr_[0]), __uint_as_float(rr_[1])); }
    const bool need = st.started ? (mx > 6.f) : true;
    if (__any(need)) {
        float dl, f;
        if (!st.started) { const bool fin = mx > -INFINITY; dl = fin ? mx : 0.f; f = 1.f; st.started = fin; }
        else { dl = fmaxf(mx, 0.f); f = __builtin_amdgcn_exp2f(-dl); }
        st.mhat += dl;
#pragma unroll
        for (int i = 0; i < 16; ++i) { p0[i] -= dl; p1[i] -= dl; }
        st.l *= f;
#pragma unroll
        for (int i = 0; i < 16; ++i) { o0[i] *= f; o1[i] *= f; }
        const float nm = -st.mhat;
#pragma unroll
        for (int i = 0; i < 16; ++i) negm[i] = nm;
    }
#pragma unroll
    for (int i = 0; i < 16; ++i) { p0[i] = __builtin_amdgcn_exp2f(p0[i]); p1[i] = __builtin_amdgcn_exp2f(p1[i]); }
    asm volatile("s_nop 1" : "+v"(p0), "+v"(p1));
    { float sa = fadd_s(p0[0], p1[0]), sb = fadd_s(p0[1], p1[1]), sc_ = fadd_s(p0[2], p1[2]), sd = fadd_s(p0[3], p1[3]);
#pragma unroll
      for (int i = 4; i < 16; i += 4) { sa = fadd_s(sa, p0[i]); sb = fadd_s(sb, p0[i + 1]); sc_ = fadd_s(sc_, p0[i + 2]); sd = fadd_s(sd, p0[i + 3]);
                                        sa = fadd_s(sa, p1[i]); sb = fadd_s(sb, p1[i + 1]); sc_ = fadd_s(sc_, p1[i + 2]); sd = fadd_s(sd, p1[i + 3]); }
      st.l += fadd_s(fadd_s(sa, sb), fadd_s(sc_, sd)); }
    bf16x8 pa[4];
    { u32x4 w;
      w.x = pk2(p0[0], p0[1]); w.y = pk2(p0[2], p0[3]); w.z = pk2(p0[4], p0[5]); w.w = pk2(p0[6], p0[7]); pa[0] = __builtin_bit_cast(bf16x8, w);
      w.x = pk2(p0[8], p0[9]); w.y = pk2(p0[10], p0[11]); w.z = pk2(p0[12], p0[13]); w.w = pk2(p0[14], p0[15]); pa[1] = __builtin_bit_cast(bf16x8, w);
      w.x = pk2(p1[0], p1[1]); w.y = pk2(p1[2], p1[3]); w.z = pk2(p1[4], p1[5]); w.w = pk2(p1[6], p1[7]); pa[2] = __builtin_bit_cast(bf16x8, w);
      w.x = pk2(p1[8], p1[9]); w.y = pk2(p1[10], p1[11]); w.z = pk2(p1[12], p1[13]); w.w = pk2(p1[14], p1[15]); pa[3] = __builtin_bit_cast(bf16x8, w); }
    __builtin_amdgcn_sched_barrier(0);

#pragma unroll
    for (int ks = 0; ks < 4; ++ks) { o0 = MFMA32(v0[ks], pa[ks], o0); o1 = MFMA32(v1[ks], pa[ks], o1); }
#ifdef PROBE_MFMA2
    { bf16x8 zq; for (int e = 0; e < 8; ++e) zq[e] = 0; asm volatile("" : "+v"(zq));
#pragma unroll
      for (int ks = 0; ks < 4; ++ks) { o0 = MFMA32(v0[ks], zq, o0); o1 = MFMA32(v1[ks], zq, o1); } }
#endif

}

template <bool BIAS, bool REV>
__device__ __forceinline__ void run_pass(LAS char* lds, const bf16_t* Kg, const bf16_t* Vg, int pitch, const float* cfg, unsigned long long tiles,
                                         const bf16x8 (&qf)[4], const bf16x8& qaug, f32x16& o0, f32x16& o1, f32x16& negm, Soft& st,
                                         int lo, int hi, unsigned long long selbits, int wmaxkey, int tid, int lane) {
    if (!tiles) return;
    const int row = tid >> 3, ch = tid & 7;
    const size_t goff = (size_t)row * pitch + ch * 8;
    const int koff = row * KROW + ch * 16, voff = row * VROW + ch * 16;
#define ATT_NEXT(dst_) do { dst_ = -1; if (tiles) { dst_ = REV ? 63 - __builtin_clzll(tiles) : __builtin_ctzll(tiles); tiles &= ~(1ull << dst_); } } while (0)
#define ATT_GLOAD(kr_, vr_, cr_, t_) do { kr_ = *(const u32x4*)(Kg + (size_t)(t_) * 64 * pitch + goff); vr_ = *(const u32x4*)(Vg + (size_t)(t_) * 64 * pitch + goff); \
        if (BIAS && tid < 64) cr_ = cfg[(t_) * 64 + tid]; } while (0)
#define ATT_LWRITE(kr_, vr_, cr_, b_) do { *(LAS u32x4*)(lds + L_K + (b_) * KTILEB + koff) = kr_; *(LAS u32x4*)(lds + L_V + (b_) * VTILEB + voff) = vr_; \
        if (BIAS && tid < 64) { const float x_ = -cr_; const unsigned h_ = pk2(x_, 0.f) & 0xffffu; const float r1_ = x_ - bflo(h_); \
        const unsigned m_ = pk2(r1_, 0.f) & 0xffffu; const float r2_ = r1_ - bflo(m_); const unsigned l_ = pk2(r2_, 0.f) & 0xffffu; \
        *(LAS u32x4*)(lds + L_K + (b_) * KTILEB + tid * KROW + 128) = (u32x4){h_ | (m_ << 16), l_, 0u, 0u}; } } while (0)
#define ATT_COMPUTE(t_, b_) do { if ((t_) * 64 <= wmaxkey) tile_compute<BIAS>(lds + L_K + (b_) * KTILEB, lds + L_V + (b_) * VTILEB, qf, qaug, o0, o1, negm, st, (t_) * 64, lo, hi, ((selbits >> (t_)) & 1ull) != 0ull, lane); } while (0)
    int t0, t1, t2;
    u32x4 krA, vrA, krB, vrB; float crA = 0.f, crB = 0.f;
    ATT_NEXT(t0); ATT_NEXT(t1);
    ATT_GLOAD(krA, vrA, crA, t0);
    if (t1 >= 0) ATT_GLOAD(krB, vrB, crB, t1);
    ATT_LWRITE(krA, vrA, crA, 0);
    __syncthreads();
    for (;;) {
        ATT_NEXT(t2);
        if (t2 >= 0) ATT_GLOAD(krA, vrA, crA, t2);
        ATT_COMPUTE(t0, 0);
        if (t1 < 0) break;
        ATT_LWRITE(krB, vrB, crB, 1);
        __syncthreads();
        ATT_NEXT(t0);
        if (t0 >= 0) ATT_GLOAD(krB, vrB, crB, t0);
        ATT_COMPUTE(t1, 1);
        if (t2 < 0) break;
        ATT_LWRITE(krA, vrA, crA, 0);
        __syncthreads();
        t1 = t0; t0 = t2;
    }
    __syncthreads();
#undef ATT_NEXT
#undef ATT_GLOAD
#undef ATT_LWRITE
#undef ATT_COMPUTE
}

constexpr int L_K2 = 0, L_V2 = 4 * KTILEB;
static_assert(L_V2 + 4 * VTILEB <= 131072, "FoX pair buffers");
__device__ __forceinline__ void run_pass_fox2(LAS char* lds, const bf16_t* Kg, const bf16_t* Vg, int pitch, const float* cfg, int ntl,
                                              const bf16x8 (&qf)[4], const bf16x8& qaug, f32x16& o0, f32x16& o1, f32x16& negm, Soft& st,
                                              int hi, int wmaxkey, int tid, int lane) {
    const int row = tid >> 3, ch = tid & 7;
    const size_t goff = (size_t)row * pitch + ch * 8;
    const int koff = row * KROW + ch * 16, voff = row * VROW + ch * 16;
#define F2_GLOAD(i_, t_) do { kr[i_] = *(const u32x4*)(Kg + (size_t)(t_) * 64 * pitch + goff); vr[i_] = *(const u32x4*)(Vg + (size_t)(t_) * 64 * pitch + goff); \
        if (tid < 64) cr[i_] = cfg[(t_) * 64 + tid]; } while (0)
#define F2_LWRITE(i_, b_) do { *(LAS u32x4*)(lds + L_K2 + (2 * (b_) + (i_)) * KTILEB + koff) = kr[i_]; *(LAS u32x4*)(lds + L_V2 + (2 * (b_) + (i_)) * VTILEB + voff) = vr[i_]; \
        if (tid < 64) { const float x_ = -cr[i_]; const unsigned h_ = pk2(x_, 0.f) & 0xffffu; const float r1_ = x_ - bflo(h_); \
        const unsigned m_ = pk2(r1_, 0.f) & 0xffffu; const float r2_ = r1_ - bflo(m_); const unsigned l_ = pk2(r2_, 0.f) & 0xffffu; \
        *(LAS u32x4*)(lds + L_K2 + (2 * (b_) + (i_)) * KTILEB + tid * KROW + 128) = (u32x4){h_ | (m_ << 16), l_, 0u, 0u}; } } while (0)
#define F2_COMPUTE(t_, i_, b_) do { if ((t_) * 64 <= wmaxkey) tile_compute<true>(lds + L_K2 + (2 * (b_) + (i_)) * KTILEB, lds + L_V2 + (2 * (b_) + (i_)) * VTILEB, qf, qaug, o0, o1, negm, st, (t_) * 64, 0, hi, true, lane); } while (0)
    u32x4 kr[2], vr[2]; float cr[2] = {0.f, 0.f};
    int ta = ntl - 1;
    F2_GLOAD(0, ta); F2_GLOAD(1, ta - 1);
    F2_LWRITE(0, 0); F2_LWRITE(1, 0);
    __syncthreads();
    int b = 0;
    for (;;) {
        const int tn = ta - 2;
        if (tn >= 0) { F2_GLOAD(0, tn); F2_GLOAD(1, tn - 1); }
        F2_COMPUTE(ta, 0, b);
        F2_COMPUTE(ta - 1, 1, b);
        if (tn < 0) break;
        F2_LWRITE(0, b ^ 1); F2_LWRITE(1, b ^ 1);
        __syncthreads();
        b ^= 1; ta = tn;
    }
    __syncthreads();
#undef F2_GLOAD
#undef F2_LWRITE
#undef F2_COMPUTE
}

struct AttnArgs { const bf16_t* proj; const float* small; const float* cfl; const bf16_t* kc; const bf16_t* vc; bf16_t* onsa; bf16_t* ofox; };

__device__ __forceinline__ void load_q(bf16x8 (&qf)[4], const bf16_t* qrow, int h) {
#pragma unroll
    for (int d0 = 0; d0 < 4; ++d0) qf[d0] = *(const bf16x8*)(qrow + d0 * 16 + h * 8);
}
__device__ __forceinline__ void store_o(bf16_t* orow, const f32x16& o0, const f32x16& o1, int h) {
#pragma unroll
    for (int g = 0; g < 4; ++g) {
        unsigned long long w0 = (unsigned long long)pk2(o0[4 * g], o0[4 * g + 1]) | ((unsigned long long)pk2(o0[4 * g + 2], o0[4 * g + 3]) << 32);
        unsigned long long w1 = (unsigned long long)pk2(o1[4 * g], o1[4 * g + 1]) | ((unsigned long long)pk2(o1[4 * g + 2], o1[4 * g + 3]) << 32);
        *(unsigned long long*)(orow + 8 * g + 4 * h) = w0;
        *(unsigned long long*)(orow + 32 + 8 * g + 4 * h) = w1;
    }
}

__device__ __forceinline__ void fox_unit(LAS char* lds, const AttnArgs& A, int b, int hh, int qb, int tid) {
    const int lane = tid & 63, wave = __builtin_amdgcn_readfirstlane(tid >> 6), r32 = lane & 31, h = lane >> 5;
    const int q0 = qb * 256, tq = q0 + 32 * wave + r32;
    const size_t row = (size_t)b * T + tq;
    bf16x8 qf[4]; load_q(qf, A.proj + row * PITCH + C_QF + 64 * hh, h);
    f32x16 o0, o1, negm;
#pragma unroll
    for (int i = 0; i < 16; ++i) { o0[i] = 0.f; o1[i] = 0.f; negm[i] = 0.f; }
    Soft st{0.f, 0.f, false};
    bf16x8 qaug;
#pragma unroll
    for (int i = 0; i < 8; ++i) qaug[i] = (short)((h == 0 && i < 3) ? 0x3F80 : 0);
    const int ntl = 4 * qb + 4;
    const bf16_t* kb = A.proj + (size_t)b * T * PITCH + 64 * hh;
    run_pass_fox2(lds, kb + C_KF, kb + C_VF, PITCH, A.cfl + (size_t)(b * 8 + hh) * T, ntl, qf, qaug, o0, o1, negm, st, tq, q0 + 32 * wave + 31, tid, lane);
    float l = st.l;
    l += __shfl_xor(l, 32);
    const float inv = 1.f / l;
#pragma unroll
    for (int i = 0; i < 16; ++i) { o0[i] *= inv; o1[i] *= inv; }
    store_o(A.ofox + row * 512 + 64 * hh, o0, o1, h);
}

__device__ __forceinline__ void nsa_unit(LAS char* lds, const AttnArgs& A, int b, int g, int qb, int tid) {
    const int lane = tid & 63, wave = __builtin_amdgcn_readfirstlane(tid >> 6), r32 = lane & 31, h = lane >> 5;
    const int hl = wave >> 1, head = 4 * g + hl, tok = 32 * (wave & 1) + r32, tq = 64 * qb + tok;
    const size_t row = (size_t)b * T + tq;
    bf16x8 qf[4]; load_q(qf, A.proj + row * PITCH + C_QN + 64 * head, h);
    const float* gp = A.small + row * 32 + head * 3;
    const float g0 = sigmoidf_(gp[0]), g1 = sigmoidf_(gp[1]), g2 = sigmoidf_(gp[2]);
    f32x16 o0, o1, negm;
    LAS float* Tst = (LAS float*)(lds + L_IMP) + wave * 2048 + lane;
    bf16x8 qaug;
#pragma unroll
    for (int i = 0; i < 8; ++i) qaug[i] = 0;
#pragma unroll
    for (int i = 0; i < 16; ++i) { o0[i] = 0.f; o1[i] = 0.f; negm[i] = 0.f; }
    Soft st{0.f, 0.f, false};
    float l;
    const int ntc = ((4 * qb + 2) >> 6) + 1;
    const unsigned long long ctiles = (1ull << ntc) - 1ull;
    const int chi = (tq >= 31) ? ((tq - 31) >> 4) : -1;
    const bf16_t* kcb = A.kc + ((size_t)b * 512 + g) * 64; const bf16_t* vcb = A.vc + ((size_t)b * 512 + g) * 64;
    run_pass<false, false>(lds, kcb, vcb, 128, nullptr, ctiles, qf, qaug, o0, o1, negm, st, 0, chi, ~0ull, 0x7fffffff, tid, lane);
    l = st.l; l += __shfl_xor(l, 32);
    const float invl = (l > 0.f) ? 1.f / l : 0.f;
    const float scmp = g0 * invl;
    LAS unsigned long long* selp = (LAS unsigned long long*)(lds + L_SEL);
    LAS unsigned long long* unip = (LAS unsigned long long*)(lds + L_UNI);
    if (qb >= 16) {
        LAS float* imp = (LAS float*)(lds + L_IMP) + (hl * 64 + tok) * 64;
        float carry = 0.f;
        const int krow_ = tid >> 3, kch = tid & 7;
        { u32x4 kk[4];
#pragma unroll
          for (int kt = 0; kt < 4; ++kt) if (kt < ntc) kk[kt] = *(const u32x4*)(kcb + (size_t)(kt * 64 + krow_) * 128 + kch * 8);
#pragma unroll
          for (int kt = 0; kt < 4; ++kt) if (kt < ntc) *(LAS u32x4*)(lds + ((kt < 2) ? (L_K + kt * KTILEB) : (L_V + (kt - 2) * VTILEB)) + krow_ * KROW + kch * 16) = kk[kt]; }
        __syncthreads();
        for (int kt = 0; kt < ntc; ++kt) {
            f32x16 p0, p1;
            tile_scores<false>(lds + ((kt < 2) ? (L_K + kt * KTILEB) : (L_V + (kt - 2) * VTILEB)), qf, qaug, negm, p0, p1, kt * 64, 0, chi, true, lane);
#pragma unroll
            for (int half = 0; half < 2; ++half) {
                float s[4], e[4], pe[4];
#pragma unroll
                for (int gi = 0; gi < 4; ++gi) {
                    float a0, a1, a2, a3;
                    if (half == 0) { a0 = p0[4 * gi]; a1 = p0[4 * gi + 1]; a2 = p0[4 * gi + 2]; a3 = p0[4 * gi + 3]; }
                    else { a0 = p1[4 * gi]; a1 = p1[4 * gi + 1]; a2 = p1[4 * gi + 2]; a3 = p1[4 * gi + 3]; }
                    a0 = __builtin_amdgcn_exp2f(a0) * invl; a1 = __builtin_amdgcn_exp2f(a1) * invl; a2 = __builtin_amdgcn_exp2f(a2) * invl; a3 = __builtin_amdgcn_exp2f(a3) * invl;
                    s[gi] = (a0 + a1) + (a2 + a3); e[gi] = a3;
                }
#pragma unroll
                for (int gi = 0; gi < 4; ++gi) pe[gi] = __shfl_xor(e[gi], 32);
                const int nbase = kt * 16 + 8 * half;
#pragma unroll
                for (int gi = 0; gi < 4; ++gi) {
                    const float add = (h == 1) ? pe[gi] : (gi == 0 ? carry : pe[gi > 0 ? gi - 1 : 0]);
                    imp[nbase + 2 * gi + h] = s[gi] + add;
                }
                carry = pe[3];
            }
        }
        __syncthreads();
        const LAS float* impa = (const LAS float*)(lds + L_IMP);
        float vv[8]; int rk[8];
#pragma unroll
        for (int i = 0; i < 8; ++i) { const int tk = 8 * wave + i;
            vv[i] = ((impa[(0 * 64 + tk) * 64 + lane] + impa[(1 * 64 + tk) * 64 + lane]) + impa[(2 * 64 + tk) * 64 + lane]) + impa[(3 * 64 + tk) * 64 + lane]; rk[i] = 0; }
        for (int j = 1; j <= qb - 2; ++j) {
#pragma unroll
            for (int i = 0; i < 8; ++i) {
                const float vj = __uint_as_float((unsigned)__builtin_amdgcn_readlane((int)__float_as_uint(vv[i]), j));
                rk[i] += ((vj > vv[i]) || (vj == vv[i] && j < lane)) ? 1 : 0;
            }
        }
        const bool cand = (lane >= 1) && (lane <= qb - 2);
#pragma unroll
        for (int i = 0; i < 8; ++i) {
            const unsigned long long msk = __ballot(cand && rk[i] < 13) | 1ull | (1ull << qb) | (1ull << (qb - 1));
            if (lane == 0) selp[8 * wave + i] = msk;
        }
    } else {
        if (tid < 64) selp[tid] = (2ull << qb) - 1ull;
    }
    __syncthreads();
    if (wave == 0) {
        unsigned long long v = selp[lane];
        unsigned lo32 = (unsigned)v, hi32 = (unsigned)(v >> 32);
#pragma unroll
        for (int o = 1; o < 64; o <<= 1) { lo32 |= __shfl_xor(lo32, o); hi32 |= __shfl_xor(hi32, o); }
        if (lane == 0) unip[0] = ((unsigned long long)hi32 << 32) | lo32;
    }
    __syncthreads();
    const unsigned long long mysel = selp[tok];
    const unsigned long long uni = unip[0];
#pragma unroll
    for (int i = 0; i < 16; ++i) { Tst[i * 64] = o0[i] * scmp; Tst[(16 + i) * 64] = o1[i] * scmp; }
#pragma unroll
    for (int i = 0; i < 16; ++i) { o0[i] = 0.f; o1[i] = 0.f; negm[i] = 0.f; }
    st = Soft{0.f, 0.f, false};
    const bf16_t* pb = A.proj + (size_t)b * T * PITCH + 64 * g;
    run_pass<false, false>(lds, pb + C_KS, pb + C_VS, PITCH, nullptr, uni, qf, qaug, o0, o1, negm, st, 0, tq, mysel, 0x7fffffff, tid, lane);
    l = st.l; l += __shfl_xor(l, 32);
    { const float s = (l > 0.f) ? g1 / l : 0.f;
#pragma unroll
      for (int i = 0; i < 16; ++i) { Tst[i * 64] += o0[i] * s; Tst[(16 + i) * 64] += o1[i] * s; } }
#pragma unroll
    for (int i = 0; i < 16; ++i) { o0[i] = 0.f; o1[i] = 0.f; negm[i] = 0.f; }
    st = Soft{0.f, 0.f, false};
    const int w0 = (qb >= 8) ? qb - 8 : 0;
    const unsigned long long wtiles = ((qb >= 63) ? ~0ull : ((2ull << qb) - 1ull)) & ~((1ull << w0) - 1ull);
    run_pass<false, false>(lds, pb + C_KW, pb + C_VW, PITCH, nullptr, wtiles, qf, qaug, o0, o1, negm, st, tq - 511, tq, ~0ull, 0x7fffffff, tid, lane);
    l = st.l; l += __shfl_xor(l, 32);
    { const float s = (l > 0.f) ? g2 / l : 0.f;
#pragma unroll
      for (int i = 0; i < 16; ++i) { o0[i] = Tst[i * 64] + o0[i] * s; o1[i] = Tst[(16 + i) * 64] + o1[i] * s; } }
    store_o(A.onsa + row * 512 + 64 * head, o0, o1, h);
    __syncthreads();
}

__device__ __forceinline__ void attn_phase(LAS char* lds, const AttnArgs& A, unsigned* queue, int tid) {
    LAS unsigned* qs = (LAS unsigned*)(lds + 131072 + 128);
    int k = 0;
    for (;;) {
        const int q = (int)((xb_xcc_id() + (unsigned)k) & 7u);
        if (tid == 0) qs[0] = __hip_atomic_fetch_add(queue + 64 * q, 1u, __ATOMIC_RELAXED, __HIP_MEMORY_SCOPE_AGENT);
        __syncthreads();
        const unsigned u = qs[0];
        __syncthreads();
        if (u >= 512u) { if (++k == 8) break; continue; }
        const int s = (int)(u >> 5), w = (int)(u & 31u);
        if (w < 16) { const int pair = 4 * q + (w >> 2); nsa_unit(lds, A, pair >> 1, pair & 1, 63 - 4 * s - (w & 3), tid); }
        else { const int ww = w - 16; fox_unit(lds, A, 4 * (s & 3) + (ww >> 2), q, 15 - 4 * (s >> 2) - (ww & 3), tid); }
    }
}
}
constexpr size_t alignup(size_t x) { return (x + 4095) & ~(size_t)4095; }
constexpr size_t WS_CTL = 0, CTL_BYTES = 65536;
constexpr size_t WS_WGU1 = CTL_BYTES;
constexpr size_t WS_WD1 = WS_WGU1 + alignup((size_t)5632 * 1024 * 2);
constexpr size_t WS_WGU2 = WS_WD1 + alignup((size_t)1024 * 2816 * 2);
constexpr size_t WS_WD2 = WS_WGU2 + alignup((size_t)5632 * 1024 * 2);
constexpr size_t WS_WIN = WS_WD2 + alignup((size_t)1024 * 2816 * 2);
constexpr size_t WS_WUPN = WS_WIN + alignup((size_t)NIN_PAD * 1024 * 2);
constexpr size_t WS_WUPF = WS_WUPN + alignup((size_t)1024 * 512 * 2);
constexpr size_t WS_WO = WS_WUPF + alignup((size_t)1024 * 512 * 2);
constexpr size_t WS_WC = WS_WO + alignup((size_t)1024 * 1024 * 2);
constexpr size_t WS_MOD = WS_WC + alignup((size_t)256 * 2048 * 2);
constexpr size_t WS_CFL = WS_MOD + alignup((size_t)16 * 9216 * 4);
constexpr size_t WS_SMALL = WS_CFL + alignup((size_t)128 * 4096 * 4);
constexpr size_t WS_FLOGT = WS_SMALL + alignup((size_t)M * 32 * 4);
constexpr size_t WS_KC = WS_FLOGT + alignup((size_t)8 * M * 4);
constexpr size_t WS_VC = WS_KC + alignup((size_t)8192 * 64 * 2);
constexpr size_t WS_HID = WS_VC + alignup((size_t)8192 * 64 * 2);
constexpr size_t WS_ACMP = WS_HID + alignup((size_t)16384 * 256 * 2);
constexpr size_t WS_H = WS_ACMP + alignup((size_t)16384 * 2048 * 2);
constexpr size_t WS_ONSA = WS_H + alignup((size_t)M * 1024 * 2);
constexpr size_t WS_OFOX = WS_ONSA + alignup((size_t)M * 512 * 2);
constexpr size_t WS_BIG = WS_OFOX + alignup((size_t)M * 512 * 2);
constexpr size_t WS_END = WS_BIG + alignup((size_t)M * PITCH * 2);
static_assert(WS_END <= ((size_t)1 << 30), "workspace map exceeds 1 GiB");

constexpr int LDS_BYTES = 147456;

struct Params { const void* in[26]; float* out; unsigned char* ws; };

__device__ __forceinline__ float wave_sum(float v) {
#pragma unroll
    for (int o = 1; o < 64; o <<= 1) v += __shfl_xor(v, o);
    return v;
}

struct MapId { int off; __device__ __forceinline__ int operator()(int n) const { return n + off; } };
struct MapGU { int off; __device__ __forceinline__ int operator()(int n) const { return 256 * (n >> 7) + (n & 127) + off; } };
struct MapIn { __device__ __forceinline__ int operator()(int n) const {
    if (n < 1280) return n; if (n < 1304) return 4864 + (n - 1280); if (n < 2840) return n - 24; if (n < 2848) return 4864 + 24 + (n - 2840); return n - 32; } };
template <class RowMap>
__device__ __forceinline__ void transpose_item(const float* W, int K, int N, bf16_t* WT, const RowMap rm, LAS float* scr, int item, int lane) {
    const int nblk = N / 32, kb = item / nblk, nb = item % nblk, k0 = 64 * kb, n0 = 32 * nb;
#pragma unroll 8
    for (int i = 0; i < 32; ++i) { const int kk = 2 * i + (lane >> 5); scr[kk * 33 + (lane & 31)] = W[(size_t)(k0 + kk) * N + n0 + (lane & 31)]; }
    asm volatile("s_waitcnt lgkmcnt(0)" ::: "memory");
    const int c = lane & 7;
#pragma unroll
    for (int j = 0; j < 4; ++j) { const int n = (lane >> 3) + 8 * j; const LAS float* s = scr + (8 * c) * 33 + n;
        u32x4 o; o.x = pk2(s[0 * 33], s[1 * 33]); o.y = pk2(s[2 * 33], s[3 * 33]); o.z = pk2(s[4 * 33], s[5 * 33]); o.w = pk2(s[6 * 33], s[7 * 33]);
        *(u32x4*)(WT + (size_t)rm(n0 + n) * K + k0 + 8 * c) = o; }
    asm volatile("s_waitcnt lgkmcnt(0)" ::: "memory");
}

template <class PT> __device__ __forceinline__ void phase_weights(LAS char* lds, const PT& p, int tid) {
    const int lane = tid & 63, wave = tid >> 6;
    LAS float* scr = (LAS float*)(lds + wave * 8704);
    const int gw = blockIdx.x * 8 + wave, NGW = gridDim.x * 8;
    unsigned char* ws = p.ws;
    constexpr int I_G = 16 * 88, I_D = 44 * 32, I_IN = 16 * 153, I_UP = 8 * 32, I_O = 16 * 32, I_C = 32 * 4;
    constexpr int NITEMS = 4 * I_G + 2 * I_D + I_IN + 2 * I_UP + I_O + 2 * I_C;
    for (int it = gw; it < NITEMS; it += NGW) {
        int r = it;
        if (r < I_G) { transpose_item((const float*)p.in[6], 1024, DFF, (bf16_t*)(ws + WS_WGU1), MapGU{0}, scr, r, lane); continue; } r -= I_G;
        if (r < I_G) { transpose_item((const float*)p.in[7], 1024, DFF, (bf16_t*)(ws + WS_WGU1), MapGU{128}, scr, r, lane); continue; } r -= I_G;
        if (r < I_G) { transpose_item((const float*)p.in[22], 1024, DFF, (bf16_t*)(ws + WS_WGU2), MapGU{0}, scr, r, lane); continue; } r -= I_G;
        if (r < I_G) { transpose_item((const float*)p.in[23], 1024, DFF, (bf16_t*)(ws + WS_WGU2), MapGU{128}, scr, r, lane); continue; } r -= I_G;
        if (r < I_D) { transpose_item((const float*)p.in[8], DFF, 1024, (bf16_t*)(ws + WS_WD1), MapId{0}, scr, r, lane); continue; } r -= I_D;
        if (r < I_D) { transpose_item((const float*)p.in[24], DFF, 1024, (bf16_t*)(ws + WS_WD2), MapId{0}, scr, r, lane); continue; } r -= I_D;
        if (r < I_IN) { transpose_item((const float*)p.in[10], 1024, 4896, (bf16_t*)(ws + WS_WIN), MapIn{}, scr, r, lane); continue; } r -= I_IN;
        if (r < I_UP) { transpose_item((const float*)p.in[18], 512, 1024, (bf16_t*)(ws + WS_WUPN), MapId{0}, scr, r, lane); continue; } r -= I_UP;
        if (r < I_UP) { transpose_item((const float*)p.in[19], 512, 1024, (bf16_t*)(ws + WS_WUPF), MapId{0}, scr, r, lane); continue; } r -= I_UP;
        if (r < I_O) { transpose_item((const float*)p.in[20], 1024, 1024, (bf16_t*)(ws + WS_WO), MapId{0}, scr, r, lane); continue; } r -= I_O;
        if (r < I_C) { transpose_item((const float*)p.in[13], 2048, 128, (bf16_t*)(ws + WS_WC), MapId{0}, scr, r, lane); continue; } r -= I_C;
        transpose_item((const float*)p.in[16], 2048, 128, (bf16_t*)(ws + WS_WC), MapId{128}, scr, r, lane);
    }
    { u32x4* z = (u32x4*)(ws + WS_WIN + (size_t)4896 * 1024 * 2); const int nz = 224 * 1024 * 2 / 16;
      for (int i = blockIdx.x * 512 + tid; i < nz; i += gridDim.x * 512) z[i] = (u32x4){0u, 0u, 0u, 0u}; }
    __syncthreads();
    const float* c = (const float*)p.in[1]; const float* w_ada = (const float*)p.in[3]; const float* b_ada = (const float*)p.in[4];
    float* mod = (float*)(ws + WS_MOD);
    if (blockIdx.x < 144) {
        LAS float* sc = (LAS float*)lds;
        LAS float* red = (LAS float*)(lds + 65536);
        for (int i = tid; i < 16 * 1024; i += 512) { const int b = i >> 10, k = i & 1023; const float v = c[i]; sc[k * 16 + b] = v * sigmoidf_(v); }
        __syncthreads();
        for (int grp = blockIdx.x; grp < 144; grp += gridDim.x) {
            float acc[16];
#pragma unroll
            for (int b = 0; b < 16; ++b) acc[b] = 0.f;
            const int j = grp * 64 + lane;
            for (int k0 = wave * 128; k0 < wave * 128 + 128; k0 += 16) {
                float wv[16];
#pragma unroll
                for (int u = 0; u < 16; ++u) wv[u] = w_ada[(size_t)(k0 + u) * 9216 + j];
#pragma unroll
                for (int u = 0; u < 16; ++u) {
                    const int k = k0 + u;
                    const f32x4 s0 = *(const LAS f32x4*)(sc + k * 16), s1 = *(const LAS f32x4*)(sc + k * 16 + 4), s2 = *(const LAS f32x4*)(sc + k * 16 + 8), s3 = *(const LAS f32x4*)(sc + k * 16 + 12);
#pragma unroll
                    for (int q = 0; q < 4; ++q) { acc[q] += s0[q] * wv[u]; acc[4 + q] += s1[q] * wv[u]; acc[8 + q] += s2[q] * wv[u]; acc[12 + q] += s3[q] * wv[u]; }
                }
            }
#pragma unroll
            for (int b = 0; b < 16; ++b) red[(wave * 16 + b) * 64 + lane] = acc[b];
            __syncthreads();
            for (int o = tid; o < 1024; o += 512) { const int b = o >> 6, cc = o & 63; float s = 0.f;
#pragma unroll
                for (int w = 0; w < 8; ++w) s += red[(w * 16 + b) * 64 + cc];
                mod[(size_t)b * 9216 + grp * 64 + cc] = s + b_ada[grp * 64 + cc]; }
            __syncthreads();
        }
    }
}

__device__ __forceinline__ void phase_norm_mod(const float* X, const float* g, const float* mod, int sh_idx, int sc_idx, bf16_t* H, int tid) {
    const int lane = tid & 63, wave = tid >> 6;
    const int gw = blockIdx.x * 8 + wave, NGW = gridDim.x * 8;
    for (int mrow = gw; mrow < M; mrow += 2 * NGW) {
        const int mrow2 = (mrow + NGW < M) ? mrow + NGW : mrow;
        const f32x4* xr = (const f32x4*)(X + (size_t)mrow * D) + lane; const f32x4* xr2 = (const f32x4*)(X + (size_t)mrow2 * D) + lane;
        f32x4 v[4], w[4]; float ss = 0.f, ss2 = 0.f;
#pragma unroll
        for (int j = 0; j < 4; ++j) { v[j] = __builtin_nontemporal_load(xr + 64 * j); w[j] = __builtin_nontemporal_load(xr2 + 64 * j); }
#pragma unroll
        for (int j = 0; j < 4; ++j) { ss += (v[j].x * v[j].x + v[j].y * v[j].y) + (v[j].z * v[j].z + v[j].w * v[j].w); ss2 += (w[j].x * w[j].x + w[j].y * w[j].y) + (w[j].z * w[j].z + w[j].w * w[j].w); }
        const float rstd = 1.0f / sqrtf(wave_sum(ss) * (1.f / D) + 1e-6f), rstd2 = 1.0f / sqrtf(wave_sum(ss2) * (1.f / D) + 1e-6f);
        const int b = mrow >> 12, b2 = mrow2 >> 12;
        unsigned long long* o8 = (unsigned long long*)(H + (size_t)mrow * D) + lane; unsigned long long* o82 = (unsigned long long*)(H + (size_t)mrow2 * D) + lane;
#pragma unroll
        for (int j = 0; j < 4; ++j) {
            const int col = 4 * lane + 256 * j;
            const f32x4 gg = *(const f32x4*)(g + col);
            { const f32x4 sc = *(const f32x4*)(mod + (size_t)b * 9216 + sc_idx * 1024 + col), sh = *(const f32x4*)(mod + (size_t)b * 9216 + sh_idx * 1024 + col);
              const f32x4 y = (v[j] * rstd) * gg * (sc + 1.f) + sh;
              o8[64 * j] = (unsigned long long)pk2(y.x, y.y) | ((unsigned long long)pk2(y.z, y.w) << 32); }
            if (mrow2 != mrow) { const f32x4 sc = *(const f32x4*)(mod + (size_t)b2 * 9216 + sc_idx * 1024 + col), sh = *(const f32x4*)(mod + (size_t)b2 * 9216 + sh_idx * 1024 + col);
              const f32x4 y = (w[j] * rstd2) * gg * (sc + 1.f) + sh;
              o82[64 * j] = (unsigned long long)pk2(y.x, y.y) | ((unsigned long long)pk2(y.z, y.w) << 32); }
        }
    }
}
__device__ __forceinline__ void phase_final_norm(float* X, const float* g, int tid) {
    const int lane = tid & 63, wave = tid >> 6;
    const int gw = blockIdx.x * 8 + wave, NGW = gridDim.x * 8;
    for (int mrow = gw; mrow < M; mrow += 2 * NGW) {
        const int mrow2 = (mrow + NGW < M) ? mrow + NGW : mrow;
        f32x4* xr = (f32x4*)(X + (size_t)mrow * D) + lane; f32x4* xr2 = (f32x4*)(X + (size_t)mrow2 * D) + lane;
        f32x4 v[4], w[4]; float ss = 0.f, ss2 = 0.f;
#pragma unroll
        for (int j = 0; j < 4; ++j) { v[j] = __builtin_nontemporal_load(xr + 64 * j); w[j] = __builtin_nontemporal_load(xr2 + 64 * j); }
#pragma unroll
        for (int j = 0; j < 4; ++j) { ss += (v[j].x * v[j].x + v[j].y * v[j].y) + (v[j].z * v[j].z + v[j].w * v[j].w); ss2 += (w[j].x * w[j].x + w[j].y * w[j].y) + (w[j].z * w[j].z + w[j].w * w[j].w); }
        const float rstd = 1.0f / sqrtf(wave_sum(ss) * (1.f / D) + 1e-6f), rstd2 = 1.0f / sqrtf(wave_sum(ss2) * (1.f / D) + 1e-6f);
#pragma unroll
        for (int j = 0; j < 4; ++j) { const f32x4 gg = *(const f32x4*)(g + 4 * lane + 256 * j); __builtin_nontemporal_store((v[j] * rstd) * gg, xr + 64 * j); if (mrow2 != mrow) __builtin_nontemporal_store((w[j] * rstd2) * gg, xr2 + 64 * j); }
    }
}

__device__ __forceinline__ void rope_cs(int pos, float (&cs)[8], float (&sn)[8]) {
    const float fp = (float)pos;
#pragma unroll
    for (int i = 0; i < 8; ++i) {
        const float inv = powf(500000.0f, -(float)i / 8.0f);
        const float ang = fp * inv;
        const double rev = (double)ang * 0.15915494309189535;
        const float fr = (float)(rev - rint(rev));
        sn[i] = __builtin_amdgcn_sinf(fr); cs[i] = __builtin_amdgcn_cosf(fr);
    }
}
__device__ __forceinline__ void rope_apply(u32x4& a, u32x4& b, const float (&cs)[8], const float (&sn)[8]) {
    float x1[8] = {bflo(a.x), bfhi(a.x), bflo(a.y), bfhi(a.y), bflo(a.z), bfhi(a.z), bflo(a.w), bfhi(a.w)};
    float x2[8] = {bflo(b.x), bfhi(b.x), bflo(b.y), bfhi(b.y), bflo(b.z), bfhi(b.z), bflo(b.w), bfhi(b.w)};
    float r1[8], r2[8];
#pragma unroll
    for (int i = 0; i < 8; ++i) { r1[i] = x1[i] * cs[i] - x2[i] * sn[i]; r2[i] = x2[i] * cs[i] + x1[i] * sn[i]; }
    a.x = pk2(r1[0], r1[1]); a.y = pk2(r1[2], r1[3]); a.z = pk2(r1[4], r1[5]); a.w = pk2(r1[6], r1[7]);
    b.x = pk2(r2[0], r2[1]); b.y = pk2(r2[2], r2[3]); b.z = pk2(r2[4], r2[5]); b.w = pk2(r2[6], r2[7]);
}

template <int PART, class PT> __device__ __forceinline__ void phase_post(const PT& p, int tid, int vbx, int vG) {
    unsigned char* ws = p.ws;
    bf16_t* proj = (bf16_t*)(ws + WS_BIG);
    const int* positions = (const int*)p.in[2];
    const int lane = tid & 63, wave = tid >> 6;
    if (PART == 1) for (int mm = vbx * 512 + tid; mm < M; mm += vG * 512) {
        float cs[8], sn[8]; rope_cs(positions[mm], cs, sn);
        bf16_t* rowp = proj + (size_t)mm * PITCH;
#pragma unroll 1
        for (int slot = 0; slot < 12; ++slot) {
            const int cb = slot < 8 ? C_QN + 64 * slot : (slot < 10 ? C_KS + 64 * (slot - 8) : C_KW + 64 * (slot - 10));
            u32x4 a = *(const u32x4*)(rowp + cb), b = *(const u32x4*)(rowp + cb + 8);
            rope_apply(a, b, cs, sn);
            *(u32x4*)(rowp + cb) = a; *(u32x4*)(rowp + cb + 8) = b;
        }
    }
    if (PART == 2) {
        bf16_t* acmp = (bf16_t*)(ws + WS_ACMP);
        const float* pe_ck = (const float*)p.in[12]; const float* pe_cv = (const float*)p.in[15];
        const int gw = blockIdx.x * 8 + wave, NGW = gridDim.x * 8;
        const int j = lane >> 1, dh = lane & 1;
        for (int row = gw; row < 16384; row += NGW) {
            const int kv = row >> 13, rr = row & 8191, b = rr >> 9, c = (rr >> 1) & 255, g = rr & 1;
            u32x4* dst = (u32x4*)(acmp + (size_t)row * 2048 + j * 64 + dh * 32);
            if (c == 255) { const u32x4 z = {0u, 0u, 0u, 0u}; dst[0] = z; dst[1] = z; dst[2] = z; dst[3] = z; continue; }
            const int t = 16 * c + j;
            const size_t mm = (size_t)b * T + t;
            const bf16_t* src = proj + mm * PITCH + (kv ? C_VC : C_KC) + 64 * g + dh * 32;
            u32x4 x[4];
#pragma unroll
            for (int q = 0; q < 4; ++q) x[q] = *(const u32x4*)(src + 8 * q);
            if (kv == 0 && dh == 0) { float cs[8], sn[8]; rope_cs(positions[mm], cs, sn); rope_apply(x[0], x[1], cs, sn); }
            const float* pe = (kv ? pe_cv : pe_ck) + j * 64 + dh * 32;
#pragma unroll
            for (int q = 0; q < 4; ++q) {
                const f32x4 e0 = *(const f32x4*)(pe + 8 * q), e1 = *(const f32x4*)(pe + 8 * q + 4);
                u32x4 o;
                o.x = pk2(bflo(x[q].x) + e0.x, bfhi(x[q].x) + e0.y); o.y = pk2(bflo(x[q].y) + e0.z, bfhi(x[q].y) + e0.w);
                o.z = pk2(bflo(x[q].z) + e1.x, bfhi(x[q].z) + e1.y); o.w = pk2(bflo(x[q].w) + e1.z, bfhi(x[q].w) + e1.w);
                dst[q] = o;
            }
        }
    }
    if (PART == 2) {
        const float* flogT = (const float*)(ws + WS_FLOGT); const float* bfg = (const float*)p.in[11];
        float* cfl = (float*)(ws + WS_CFL);
        const int gw = blockIdx.x * 8 + wave, NGW = gridDim.x * 8;
        for (int s = gw; s < 128; s += NGW) {
            const int b = s >> 3, hh = s & 7; const float bias = bfg[hh];
            const f32x4* src = (const f32x4*)(flogT + (size_t)hh * M + (size_t)b * T + 64 * lane);
            f32x4 v[16];
#pragma unroll
            for (int i = 0; i < 16; ++i) v[i] = src[i];
            float run = 0.f;
#pragma unroll
            for (int i = 0; i < 16; ++i)
#pragma unroll
                for (int j = 0; j < 4; ++j) { const float z = v[i][j] + bias; run += fminf(z, 0.f) - log1pf(expf(-fabsf(z))); v[i][j] = run; }
            float incl = run;
#pragma unroll
            for (int o = 1; o < 64; o <<= 1) { const float n = __shfl_up(incl, o); if (lane >= o) incl += n; }
            const float off = incl - run;
            f32x4* dst = (f32x4*)(cfl + (size_t)s * T + 64 * lane);
#pragma unroll
            for (int i = 0; i < 16; ++i) dst[i] = (v[i] + off) * LOG2E;
        }
    }
}

template <class PT> __device__ __forceinline__ void phase_cmp2(LAS char* lds, const PT& p, int tid) {
    unsigned char* ws = p.ws;
    const bf16_t* hid = (const bf16_t*)(ws + WS_HID);
    const float* w2k = (const float*)p.in[14]; const float* w2v = (const float*)p.in[17];
    const int lane = tid & 63, wave = tid >> 6;
    LAS float* w2s = (LAS float*)lds;
    for (int i = tid; i < 2 * 8192; i += 512) w2s[i] = (i < 8192) ? w2k[i] : w2v[i - 8192];
    __syncthreads();
    const int gw = blockIdx.x * 8 + wave, NGW = gridDim.x * 8;
    for (int row = gw; row < 16384; row += NGW) {
        const int kv = row >> 13, rr = row & 8191;
        const unsigned hv = *(const unsigned*)(hid + (size_t)row * 256 + kv * 128 + 2 * lane);
        const LAS float* wp = w2s + kv * 8192 + lane;
        float a0 = 0.f, a1 = 0.f;
#pragma unroll
        for (int j = 0; j < 64; ++j) {
            const unsigned hj = (unsigned)__builtin_amdgcn_readlane((int)hv, j);
            a0 += bflo(hj) * wp[(2 * j) * 64]; a1 += bfhi(hj) * wp[(2 * j + 1) * 64];
        }
        bf16_t* dst = (bf16_t*)(ws + (kv ? WS_VC : WS_KC)) + (size_t)rr * 64 + lane;
        *dst = (bf16_t)(pk2(a0 + a1, 0.f) & 0xffffu);
    }
    __syncthreads();
}

#define CAS __attribute__((address_space(4)))
#define RELOAD_P() do { pp = (const CAS Params*)__builtin_amdgcn_kernarg_segment_ptr(); asm volatile("" : "+s"(pp)); ws = pp->ws; x = (const float*)pp->in[0]; out = pp->out; mod = (float*)(ws + WS_MOD); H = (bf16_t*)(ws + WS_H); BIG = (bf16_t*)(ws + WS_BIG); tid = threadIdx.x; asm volatile("" : "+v"(tid)); } while (0)
__global__ void __launch_bounds__(512, 2) mega_fwd(Params p_in) {
    const CAS Params* pp;
    extern __shared__ __attribute__((aligned(16))) unsigned char lds_raw[];
    LAS unsigned char* lds = (LAS unsigned char*)lds_raw;
    cg::grid_group grid = cg::this_grid();
    { volatile LAS unsigned* stz = (volatile LAS unsigned*)(lds + 131072 + 64); if (threadIdx.x < 4) stz[threadIdx.x] = 0u; }
    __syncthreads();
    const XcdBarrier xbar = xcd_barrier_post((unsigned*)(p_in.ws + WS_CTL), (volatile LAS unsigned*)(lds + 131072 + 64));
    int tid = threadIdx.x;
    unsigned char* ws; const float* x; float* out; float* mod; bf16_t* H; bf16_t* BIG;
    const int G = gridDim.x, bx = blockIdx.x;
    RELOAD_P();

    phase_weights((LAS char*)lds, *pp, tid);
#ifdef PROBE_P0A2
    __syncthreads(); phase_weights((LAS char*)lds, *pp, tid);
#endif
    if (pp->ws == nullptr) grid.sync();
    xcd_barrier(xbar); RELOAD_P();
    phase_norm_mod(x, (const float*)pp->in[5], mod, 0, 1, H, tid);
    xcd_barrier(xbar); RELOAD_P();
#ifdef PROBE_SYNC10
    for (int i_ = 0; i_ < 10; ++i_) grid.sync();
#endif
#ifdef PROBE_NORM2
    phase_norm_mod(x, (const float*)pp->in[5], mod, 0, 1, H, tid); phase_norm_mod(x, (const float*)pp->in[5], mod, 0, 1, H, tid); phase_norm_mod(x, (const float*)pp->in[5], mod, 0, 1, H, tid);
#endif
    { pg8::Gemm g{H, (const bf16_t*)(ws + WS_WGU1), M, 5632, 1024}; pg8::StaticOrder S; S.init(M, 5632, G, bx);
      pg8::EpiSwiglu E{BIG}; pg8::gemm_phase<pg8::EpiSwiglu, pg8::StaticOrder, true, true>(lds, g, S, E);
#ifdef PROBE_P1X2
      pg8::gemm_phase<pg8::EpiSwiglu, pg8::StaticOrder, true, true>(lds, g, S, E);
#endif
    }
    xcd_barrier(xbar); RELOAD_P();
    { pg8::Gemm g{BIG, (const bf16_t*)(ws + WS_WD1), M, 1024, DFF}; pg8::StaticOrder S; S.init(M, 1024, G, bx);
      pg8::EpiResid E{x, out, mod + 2 * 1024, 0.5f}; pg8::gemm_phase<pg8::EpiResid, pg8::StaticOrder, true, true>(lds, g, S, E); }
    xcd_barrier(xbar); RELOAD_P();
    phase_norm_mod(out, (const float*)pp->in[9], mod, 3, 4, H, tid);
    xcd_barrier(xbar); RELOAD_P();
    { pg8::Gemm g{H, (const bf16_t*)(ws + WS_WIN), M, NIN_PAD, 1024}; pg8::StaticOrder S; S.init(M, NIN_PAD, G, bx);
      pg8::EpiProj E{BIG, (float*)(ws + WS_SMALL), (float*)(ws + WS_FLOGT)}; pg8::gemm_phase<pg8::EpiProj, pg8::StaticOrder, true, true>(lds, g, S, E); }
    xcd_barrier(xbar); RELOAD_P();
    phase_post<2>(*pp, tid, bx, G);
#ifdef PROBE_POST2
    grid.sync(); RELOAD_P(); phase_cmp2((LAS char*)lds, *pp, tid); phase_weights((LAS char*)lds, *pp, tid);
#endif
    xcd_barrier(xbar); RELOAD_P();
    if (bx < 64 || G <= 64) { pg8::Gemm g{(const bf16_t*)(ws + WS_ACMP), (const bf16_t*)(ws + WS_WC), 16384, 256, 2048}; pg8::StaticOrder S; S.init(16384, 256, G, bx);
      pg8::EpiGelu E{(bf16_t*)(ws + WS_HID)}; pg8::gemm_phase<pg8::EpiGelu, pg8::StaticOrder, true, true>(lds, g, S, E); }
    if (G <= 64) phase_post<1>(*pp, tid, bx, G); else if (bx >= 64) phase_post<1>(*pp, tid, bx - 64, G - 64);
    xcd_barrier(xbar); RELOAD_P();
    phase_cmp2((LAS char*)lds, *pp, tid);
    xcd_barrier(xbar); RELOAD_P();
    { att::AttnArgs A{BIG, (const float*)(ws + WS_SMALL), (const float*)(ws + WS_CFL), (const bf16_t*)(ws + WS_KC), (const bf16_t*)(ws + WS_VC), (bf16_t*)(ws + WS_ONSA), (bf16_t*)(ws + WS_OFOX)};
      att::attn_phase((LAS char*)lds, A, (unsigned*)(ws + WS_CTL + 32768), tid);
#ifdef PROBE_ATTN2_DISABLED
      __syncthreads(); att::attn_phase((LAS char*)lds, A, tid);
#endif
    }
    xcd_barrier(xbar); RELOAD_P();
    { pg8::Gemm g{(const bf16_t*)(ws + WS_ONSA), (const bf16_t*)(ws + WS_WUPN), M, 1024, 512}; pg8::StaticOrder S; S.init(M, 1024, G, bx);
      pg8::EpiGate<false> E{BIG, C_GMN, H}; pg8::gemm_phase<pg8::EpiGate<false>, pg8::StaticOrder, true, true>(lds, g, S, E); }
    RELOAD_P();
    { pg8::Gemm g{(const bf16_t*)(ws + WS_OFOX), (const bf16_t*)(ws + WS_WUPF), M, 1024, 512}; pg8::StaticOrder S; S.init(M, 1024, G, bx);
      pg8::EpiGate<true> E{BIG, C_GMF, H}; pg8::gemm_phase<pg8::EpiGate<true>, pg8::StaticOrder, true, true>(lds, g, S, E); }
    xcd_barrier(xbar); RELOAD_P();
    { pg8::Gemm g{H, (const bf16_t*)(ws + WS_WO), M, 1024, 1024}; pg8::StaticOrder S; S.init(M, 1024, G, bx);
      pg8::EpiResid E{out, out, mod + 5 * 1024, 1.0f}; pg8::gemm_phase<pg8::EpiResid, pg8::StaticOrder, true, true>(lds, g, S, E); }
    xcd_barrier(xbar); RELOAD_P();
    phase_norm_mod(out, (const float*)pp->in[21], mod, 6, 7, H, tid);
    xcd_barrier(xbar); RELOAD_P();
    { pg8::Gemm g{H, (const bf16_t*)(ws + WS_WGU2), M, 5632, 1024}; pg8::StaticOrder S; S.init(M, 5632, G, bx);
      pg8::EpiSwiglu E{BIG}; pg8::gemm_phase<pg8::EpiSwiglu, pg8::StaticOrder, true, true>(lds, g, S, E); }
    xcd_barrier(xbar); RELOAD_P();
    { pg8::Gemm g{BIG, (const bf16_t*)(ws + WS_WD2), M, 1024, DFF}; pg8::StaticOrder S; S.init(M, 1024, G, bx);
      pg8::EpiResid E{out, out, mod + 8 * 1024, 0.5f}; pg8::gemm_phase<pg8::EpiResid, pg8::StaticOrder, true, true>(lds, g, S, E); }
    xcd_barrier(xbar); RELOAD_P();
    phase_final_norm(out, (const float*)pp->in[25], tid);
}

extern "C" void kernel_launch(void* const* d_in, const int* in_sizes, int n_in, void* d_out, int out_size, void* d_ws, size_t ws_size, hipStream_t stream) {
    static int grid = 0;
    if (grid == 0) {
        if (n_in != 26 || out_size != M * D || ws_size < WS_END) { fprintf(stderr, "kernel_launch: unexpected sizes n_in %d out %d ws %zu (need %zu)\n", n_in, out_size, ws_size, (size_t)WS_END); grid = -1; return; }
        int dev = 0, cus = 0, per_cu = 0;
        hipGetDevice(&dev); hipDeviceGetAttribute(&cus, hipDeviceAttributeMultiprocessorCount, dev);
        if (hipFuncSetAttribute((const void*)mega_fwd, hipFuncAttributeMaxDynamicSharedMemorySize, LDS_BYTES) != hipSuccess) { fprintf(stderr, "kernel_launch: hipFuncSetAttribute failed\n"); grid = -1; return; }
        if (hipOccupancyMaxActiveBlocksPerMultiprocessor(&per_cu, (const void*)mega_fwd, 512, LDS_BYTES) != hipSuccess || per_cu < 1) { fprintf(stderr, "kernel_launch: occupancy query says %d\n", per_cu); per_cu = 1; }
        (void)hipGetLastError();
        grid = cus * 1;
    }
    if (grid < 0) return;
    if (hipMemsetAsync((char*)d_ws + WS_CTL, 0, CTL_BYTES, stream) != hipSuccess) { fprintf(stderr, "kernel_launch: memset failed\n"); return; }
    Params p{};
    for (int i = 0; i < 26; ++i) p.in[i] = d_in[i];
    p.out = (float*)d_out; p.ws = (unsigned char*)d_ws;
    void* args[] = {&p};
    hipError_t e = hipLaunchCooperativeKernel((const void*)mega_fwd, dim3(grid), dim3(512), args, LDS_BYTES, stream);
    if (e != hipSuccess) fprintf(stderr, "cooperative launch failed: %s (grid %d)\n", hipGetErrorString(e), grid);
}
```
